# Optimizing an MI355X kernel written in HIP

```python
import jax, jax.numpy as jnp
from jax import lax
import numpy as np

D_MODEL = 1024
BATCH = 8
SEQ = 2048
DEPTH = 1
DEC_BATCH = 32
DEC_SEQ = 32
PAST_LEN = 2048

CHUNK = 64
D_MIX = D_MODEL
RET_WIDTH = D_MIX // 2
RET_HEADS = 4
RET_DK = RET_WIDTH // RET_HEADS
RET_DV = RET_WIDTH // RET_HEADS
RET_ROPE_BASE = 10000.0
ATT_WIDTH = D_MIX - RET_WIDTH
ATT_HEADS = 8
ATT_DH = ATT_WIDTH // ATT_HEADS
ATT_ROT = ATT_DH // 4
IDX_HEADS = 8
IDX_DH = 64
IDX_ROT = IDX_DH // 4
TOPK_MAX = 256
ROPE_THETA = 500000.0
Q_BLOCK = 128
D_FF = 2816
LN_EPS = 1e-5
ALPHA = (2.0 * DEPTH) ** 0.25
BETA = (8.0 * DEPTH) ** -0.25
NEG = -1e30
IN_SIZES = (RET_WIDTH, RET_WIDTH, RET_HEADS * RET_DV, RET_HEADS * RET_DV,
            ATT_WIDTH, ATT_WIDTH, ATT_WIDTH, IDX_HEADS * IDX_DH, IDX_DH, IDX_HEADS)
IN_BETA = (1.0, 1.0, BETA, 1.0, 1.0, 1.0, BETA, 1.0, 1.0, 1.0)
D_IN = sum(IN_SIZES)

kernel_name = "hybrid_retention_dsa_streaming_encoder_step"

F32 = jnp.float32


def layer_norm(x, g, b):
    xf = x.astype(F32)
    mu = jnp.mean(xf, -1, keepdims=True)
    var = jnp.mean(jnp.square(xf - mu), -1, keepdims=True)
    return ((xf - mu) * lax.rsqrt(var + LN_EPS)).astype(x.dtype) * g + b


def head_norm(x):
    xf = x.astype(F32)
    mu = jnp.mean(xf, -1, keepdims=True)
    var = jnp.mean(jnp.square(xf - mu), -1, keepdims=True)
    return (xf - mu) * lax.rsqrt(var + LN_EPS)


def rope_angles(pos, rot_dim, base):
    inv = 1.0 / (base ** (jnp.arange(0, rot_dim, 2, dtype=F32) / rot_dim))
    ang = pos.astype(F32)[:, None] * inv[None, :]
    return jnp.cos(ang), jnp.sin(ang)


def apply_rope(x, cos, sin):
    r = 2 * cos.shape[-1]
    if x.ndim == 4:
        cos, sin = cos[:, None, :], sin[:, None, :]
    xf = x.astype(F32)
    x1, x2, xp = xf[..., : r // 2], xf[..., r // 2: r], xf[..., r:]
    return jnp.concatenate([x1 * cos - x2 * sin, x2 * cos + x1 * sin, xp], -1).astype(x.dtype)


def modulate(x, shift, scale):
    return x * (1.0 + scale[:, None, :]) + shift[:, None, :]


def post_norm(x, out, gate, weight, g, b):
    return layer_norm(ALPHA * x + weight * gate[:, None, :] * out, g, b)


def swiglu(h, w_gate, w_up, w_down):
    a = jnp.einsum('btd,df->btf', h, w_gate)
    u = jnp.einsum('btd,df->btf', h, w_up)
    return jnp.einsum('btf,fd->btd', jax.nn.silu(a) * u, w_down)


def mixer_inputs(h, pos, w_in):
    B, T, _ = h.shape
    z = jnp.einsum('btd,de->bte', h, w_in)
    split_points = [int(s) for s in np.cumsum(IN_SIZES)[:-1]]
    rq, rk, rv, rg, aq, ak, av, iq, ik, iw = jnp.split(z, split_points, axis=-1)
    rcos, rsin = rope_angles(pos, RET_DK, RET_ROPE_BASE)
    acos, asin = rope_angles(pos, ATT_ROT, ROPE_THETA)
    icos, isin = rope_angles(pos, IDX_ROT, ROPE_THETA)
    rq = apply_rope(rq.reshape(B, T, RET_HEADS, RET_DK), rcos, rsin)
    rk = apply_rope(rk.reshape(B, T, RET_HEADS, RET_DK), rcos, rsin) * (RET_DK ** -0.5)
    rv = rv.reshape(B, T, RET_HEADS, RET_DV)
    rg = rg.reshape(B, T, RET_HEADS, RET_DV)
    aq = apply_rope(aq.reshape(B, T, ATT_HEADS, ATT_DH), acos, asin)
    ak = apply_rope(ak.reshape(B, T, ATT_HEADS, ATT_DH), acos, asin)
    av = av.reshape(B, T, ATT_HEADS, ATT_DH)
    iq = apply_rope(iq.reshape(B, T, IDX_HEADS, IDX_DH), icos, isin)
    ik = apply_rope(ik, icos, isin)
    iw = iw * (IDX_HEADS ** -0.5)
    return rq, rk, rv, rg, aq, ak, av, iq, ik, iw


def retention_log_decay():
    return jnp.log(1.0 - 2.0 ** (-5.0 - jnp.arange(RET_HEADS, dtype=F32)))


def retention_chunk(S, q, k, v):
    lg = retention_log_decay()
    C = q.shape[1]
    n = jnp.arange(C, dtype=F32)
    rel = n[:, None] - n[None, :]
    D = jnp.where(rel[None] >= 0, jnp.exp(lg[:, None, None] * jnp.maximum(rel, 0.0)[None]), 0.0)
    qf, kf, vf = q.astype(F32), k.astype(F32), v.astype(F32)
    scores = jnp.einsum('bnhd,bmhd->bhnm', qf, kf) * D[None]
    inner = jnp.einsum('bhnm,bmhe->bnhe', scores, vf)
    cross = jnp.einsum('bnhd,bhde->bnhe', qf, S) * jnp.exp(lg[None, :] * (n[:, None] + 1.0))[None, :, :, None]
    decay_k = jnp.exp(lg[None, :] * (C - 1.0 - n)[:, None])
    S_new = jnp.exp(lg * C)[None, :, None, None] * S + jnp.einsum('bmhd,mh,bmhe->bhde', kf, decay_k, vf)
    return S_new, inner + cross


def retention_prompt(q, k, v):
    B, T, H, dk = q.shape
    nc = T // CHUNK

    def to_chunks(a):
        return a.reshape(B, nc, CHUNK, *a.shape[2:]).swapaxes(0, 1)

    S0 = jnp.zeros((B, H, dk, RET_DV), F32)
    S, o = lax.scan(lambda s, qkv: retention_chunk(s, *qkv), S0, (to_chunks(q), to_chunks(k), to_chunks(v)))
    return S, o.swapaxes(0, 1).reshape(B, T, H, RET_DV)


def dsa_attend(q, iq, iw, qpos, k, v, ik, topk):
    L = k.shape[1]
    s = jnp.einsum('bqhd,bsd->bqhs', iq.astype(F32), ik.astype(F32)) * (IDX_DH ** -0.5)
    index_score = jnp.einsum('bqh,bqhs->bqs', iw.astype(F32), jax.nn.relu(s))
    limit = (qpos // CHUNK + 1) * CHUNK
    admissible = jnp.arange(L, dtype=jnp.int32)[None, :] < limit[:, None]
    index_score = jnp.where(admissible[None], index_score, NEG)
    _, idx = lax.top_k(index_score, topk)
    valid = idx < limit[None, :, None]
    kg = jax.vmap(lambda kk, ii: kk[ii])(k, idx)
    vg = jax.vmap(lambda vv, ii: vv[ii])(v, idx)
    logits = jnp.einsum('bqhd,bqkhd->bqhk', q.astype(F32), kg.astype(F32)) * (ATT_DH ** -0.5)
    logits = jnp.where(valid[:, :, None, :], logits, NEG)
    p = jax.nn.softmax(logits, axis=-1)
    return jnp.einsum('bqhk,bqkhd->bqhd', p, vg.astype(F32)).astype(q.dtype)


def dsa_prompt(q, k, v, iq, ik, iw):
    B, T = q.shape[:2]
    nb = T // Q_BLOCK
    topk = min(TOPK_MAX, T // 4)

    def blocks(a):
        return a.reshape(B, nb, Q_BLOCK, *a.shape[2:]).swapaxes(0, 1)

    qpos = jnp.arange(T, dtype=jnp.int32).reshape(nb, Q_BLOCK)
    o = lax.map(lambda a: dsa_attend(a[0], a[1], a[2], a[3], k, v, ik, topk),
                (blocks(q), blocks(iq), blocks(iw), qpos))
    return o.swapaxes(0, 1).reshape(B, T, ATT_HEADS, ATT_DH)


def encoder_layer(x, c, w_cond, b_cond, f1_gate, f1_up, f1_down, ln1_g, ln1_b, w_in, w_out, ln2_g, ln2_b,
                  f2_gate, f2_up, f2_down, ln3_g, ln3_b, past):
    B, T, _ = x.shape
    mod = jnp.einsum('bd,de->be', jax.nn.silu(c), w_cond) + b_cond
    sh1, sc1, gt1, sh2, sc2, gt2, sh3, sc3, gt3 = jnp.split(mod, 9, axis=-1)
    x = post_norm(x, swiglu(modulate(x, sh1, sc1), f1_gate, f1_up, f1_down), 1.0 + gt1, 0.5, ln1_g, ln1_b)
    h = modulate(x, sh2, sc2)
    if past is None:
        pos = jnp.arange(T, dtype=jnp.int32)
    else:
        past_k, past_v, past_ik, ret_s0 = past
        pos = past_k.shape[1] + jnp.arange(T, dtype=jnp.int32)
    rq, rk, rv, rg, aq, ak, av, iq, ik, iw = mixer_inputs(h, pos, w_in)
    if past is None:
        ret_s, o_ret = retention_prompt(rq, rk, rv)
        o_att = dsa_prompt(aq, ak, av, iq, ik, iw)
    else:
        ret_s, o_ret = retention_chunk(ret_s0.astype(F32), rq, rk, rv)
        k_all = jnp.concatenate([past_k, ak], axis=1)
        v_all = jnp.concatenate([past_v, av], axis=1)
        ik_all = jnp.concatenate([past_ik, ik], axis=1)
        L = k_all.shape[1]
        o_att = dsa_attend(aq, iq, iw, pos, k_all, v_all, ik_all, min(TOPK_MAX, L // 4))
    o_ret = (head_norm(o_ret) * jax.nn.silu(rg.astype(F32))).astype(x.dtype).reshape(B, T, RET_WIDTH)
    mixed = jnp.concatenate([o_ret, o_att.reshape(B, T, ATT_WIDTH)], axis=-1)
    x = post_norm(x, jnp.einsum('btm,md->btd', mixed, w_out), 1.0 + gt2, 1.0, ln2_g, ln2_b)
    x = post_norm(x, swiglu(modulate(x, sh3, sc3), f2_gate, f2_up, f2_down), 1.0 + gt3, 0.5, ln3_g, ln3_b)
    return x, (ak, av, ik, ret_s.astype(x.dtype))


def setup_inputs(seed: int = 0) -> dict:
    key = jax.random.key(seed)
    ks = jax.random.split(key, 32)
    nrm = jax.random.normal
    d_in_scale = jnp.asarray(np.concatenate([np.full((s,), b, np.float32) for s, b in zip(IN_SIZES, IN_BETA)]))
    return {
        'x_prompt': nrm(ks[0], (BATCH, SEQ, D_MODEL), F32),
        'x_sample': nrm(ks[1], (DEC_BATCH, DEC_SEQ, D_MODEL), F32),
        'c_prompt': nrm(ks[2], (BATCH, D_MODEL), F32),
        'c_sample': nrm(ks[3], (DEC_BATCH, D_MODEL), F32),
        'cache_k': nrm(ks[4], (DEPTH, DEC_BATCH, PAST_LEN, ATT_HEADS, ATT_DH), F32),
        'cache_v': nrm(ks[5], (DEPTH, DEC_BATCH, PAST_LEN, ATT_HEADS, ATT_DH), F32),
        'cache_idx_k': nrm(ks[6], (DEPTH, DEC_BATCH, PAST_LEN, IDX_DH), F32),
        'state_ret': nrm(ks[7], (DEPTH, DEC_BATCH, RET_HEADS, RET_DK, RET_DV), F32),
        'w_cond': nrm(ks[8], (DEPTH, D_MODEL, 9 * D_MODEL), F32) * (0.1 * D_MODEL ** -0.5),
        'b_cond': nrm(ks[9], (DEPTH, 9 * D_MODEL), F32) * 0.01,
        'ffn1_w_gate': nrm(ks[10], (DEPTH, D_MODEL, D_FF), F32) * D_MODEL ** -0.5,
        'ffn1_w_up': nrm(ks[11], (DEPTH, D_MODEL, D_FF), F32) * D_MODEL ** -0.5,
        'ffn1_w_down': nrm(ks[12], (DEPTH, D_FF, D_MODEL), F32) * (BETA * D_FF ** -0.5),
        'ln1_g': 1.0 + 0.02 * nrm(ks[13], (DEPTH, D_MODEL), F32),
        'ln1_b': 0.02 * nrm(ks[14], (DEPTH, D_MODEL), F32),
        'w_in': nrm(ks[15], (DEPTH, D_MODEL, D_IN), F32) * (D_MODEL ** -0.5) * d_in_scale,
        'w_out': nrm(ks[16], (DEPTH, D_MIX, D_MODEL), F32) * (BETA * D_MIX ** -0.5),
        'ln2_g': 1.0 + 0.02 * nrm(ks[17], (DEPTH, D_MODEL), F32),
        'ln2_b': 0.02 * nrm(ks[18], (DEPTH, D_MODEL), F32),
        'ffn2_w_gate': nrm(ks[19], (DEPTH, D_MODEL, D_FF), F32) * D_MODEL ** -0.5,
        'ffn2_w_up': nrm(ks[20], (DEPTH, D_MODEL, D_FF), F32) * D_MODEL ** -0.5,
        'ffn2_w_down': nrm(ks[21], (DEPTH, D_FF, D_MODEL), F32) * (BETA * D_FF ** -0.5),
        'ln3_g': 1.0 + 0.02 * nrm(ks[22], (DEPTH, D_MODEL), F32),
        'ln3_b': 0.02 * nrm(ks[23], (DEPTH, D_MODEL), F32),
    }


def reference(x_prompt, x_sample, c_prompt, c_sample, cache_k, cache_v, cache_idx_k, state_ret,
              w_cond, b_cond, ffn1_w_gate, ffn1_w_up, ffn1_w_down, ln1_g, ln1_b, w_in, w_out, ln2_g, ln2_b,
              ffn2_w_gate, ffn2_w_up, ffn2_w_down, ln3_g, ln3_b):
    y_prompt, y_sample = x_prompt, x_sample
    st_p, st_s = [], []
    for l in range(DEPTH):
        params = (w_cond[l], b_cond[l], ffn1_w_gate[l], ffn1_w_up[l], ffn1_w_down[l], ln1_g[l], ln1_b[l],
                  w_in[l], w_out[l], ln2_g[l], ln2_b[l], ffn2_w_gate[l], ffn2_w_up[l], ffn2_w_down[l],
                  ln3_g[l], ln3_b[l])
        y_prompt, sp = encoder_layer(y_prompt, c_prompt, *params, past=None)
        y_sample, ss = encoder_layer(y_sample, c_sample, *params,
                                     past=(cache_k[l], cache_v[l], cache_idx_k[l], state_ret[l]))
        st_p.append(sp)
        st_s.append(ss)
    new_k_prompt = jnp.stack([s[0] for s in st_p])
    new_v_prompt = jnp.stack([s[1] for s in st_p])
    new_idx_k_prompt = jnp.stack([s[2] for s in st_p])
    state_ret_prompt = jnp.stack([s[3] for s in st_p])
    new_k_sample = jnp.stack([s[0] for s in st_s])
    new_v_sample = jnp.stack([s[1] for s in st_s])
    new_idx_k_sample = jnp.stack([s[2] for s in st_s])
    state_ret_sample = jnp.stack([s[3] for s in st_s])
    return (y_prompt, y_sample, new_k_prompt, new_v_prompt, new_idx_k_prompt, state_ret_prompt,
            new_k_sample, new_v_sample, new_idx_k_sample, state_ret_sample)
```

```cpp
#include <hip/hip_runtime.h>
#include <cstdio>
#include <cstdint>

constexpr int MP = 16384, MS = 1024, MROWS = MP + MS;
constexpr int DM = 1024, FF = 2816, NGU = 2 * FF, NIN = 4352, DIN = 4168, NMOD = 9 * DM;
constexpr float LN_EPS = 1e-5f;
constexpr float ALPHA = 1.189207115002721f;
constexpr float C2Q = 0.125f * 1.4426950408889634f;
constexpr float RK_SCALE = 0.08838834764831845f;
constexpr float IW_SCALE = 0.35355339059327373f * 0.125f;
constexpr size_t O_YP = 0, O_YS = 16777216, O_NKP = 17825792, O_NVP = 26214400, O_NIP = 34603008, O_SRP = 35651584,
                 O_NKS = 36175872, O_NVS = 36700160, O_NIS = 37224448, O_SRS = 37289984, O_END = 39387136;
#define MK_N_LAUNCHES 1
namespace pg8 {
#define PG8_LAS __attribute__((address_space(3)))
typedef unsigned short bf16_t;
typedef short bf16x8 __attribute__((ext_vector_type(8)));
typedef float f32x4 __attribute__((ext_vector_type(4)));
typedef unsigned u32x4 __attribute__((ext_vector_type(4)));
constexpr int BM = 256, BK = 64, HALF = 128, HTB = HALF * BK * 2  , STAGE_BYTES = 8 * HTB, NXCD = 8, WGM = 8;

__host__ __device__ __forceinline__ int lds_byte(int r, int c) { const int st = (r >> 4) * 2 + (c >> 5), rr = r & 15, cc = c & 31, ob = rr * 64 + cc * 2; return st * 1024 + (ob ^ (((ob >> 9) & 1) << 5)); }
__host__ __device__ __forceinline__ void stage_rc(int b, int& R, int& C) { const int st = b / 1024, sb = b % 1024, swz = sb ^ (((sb >> 9) & 1) << 5); R = (st >> 1) * 16 + swz / 64; C = (st & 1) * 32 + (swz % 64) / 2; }
__host__ __device__ __forceinline__ int perm32(int rho) { const int n = rho >> 4, i = rho & 15; return 8 * (i >> 2) + 4 * n + (i & 3); }

struct Unit { int pm, pn; };
struct Gemm { const bf16_t* A; const bf16_t* Bt; int M, N, K; };

struct StaticOrder {
    int nM, nN, nwg, G, c;
    __host__ __device__ void init(int M, int N, int G_, int c_) { nM = M / BM; nN = N / BM; nwg = nM * nN; G = G_; c = c_; }
    __host__ __device__ bool next(int i, Unit& u) const {
        const long L = (long)i * G + c; if (L >= nwg) return false;
        int wgid = (int)L; { const int q = nwg / NXCD, r = nwg % NXCD, xcd = wgid % NXCD, off = wgid / NXCD; wgid = (xcd < r ? xcd * (q + 1) : r * (q + 1) + (xcd - r) * q) + off; }
        const int nig = WGM * nN, gid = wgid / nig, fm = gid * WGM, gsz = (nM - fm) < WGM ? (nM - fm) : WGM;
        u.pm = fm + ((wgid % nig) % gsz); u.pn = (wgid % nig) / gsz; return true;
    }
    __device__ __forceinline__ void a_ready(const Unit&) const {}
    __device__ __forceinline__ void done(const Unit&) const {}
};

__device__ __forceinline__ unsigned cvt_pk_bf16(float lo, float hi) { unsigned r; asm volatile("v_cvt_pk_bf16_f32 %0, %1, %2" : "=v"(r) : "v"(lo), "v"(hi)); return r; }
typedef float f32x2 __attribute__((ext_vector_type(2)));
typedef unsigned u32x2 __attribute__((ext_vector_type(2)));
__device__ __forceinline__ float silu_f(float g) { return g * __builtin_amdgcn_rcpf(1.f + __builtin_amdgcn_exp2f(-1.4426950408889634f * g)); }
__device__ __forceinline__ int batch_of_row(int r) { return r < MP ? (r >> 11) : 8 + ((r - MP) >> 5); }
__device__ __forceinline__ int pos_of_row(int r) { return r < MP ? (r & 2047) : 2048 + (r & 31); }
__device__ __forceinline__ u32x4 pack8(const f32x4 a, const f32x4 b) { u32x4 w; w.x = cvt_pk_bf16(a[0], a[1]); w.y = cvt_pk_bf16(a[2], a[3]); w.z = cvt_pk_bf16(b[0], b[1]); w.w = cvt_pk_bf16(b[2], b[3]); return w; }

struct EpiSwiGLU {
    static constexpr bool PERM = true, AFTER_DRAIN = false;
    bf16_t* O;
    __device__ __forceinline__ void operator()(const f32x4 (&acc)[2][2][4][2], const Unit& u, int wr, int wc, int fr, int fq) const {
        const int row0 = u.pm * BM + wr * 64 + fr, col0 = u.pn * 128 + wc * 32 + 8 * fq;
#pragma unroll
        for (int ai = 0; ai < 2; ++ai)
#pragma unroll
            for (int m = 0; m < 4; ++m) {
                bf16_t* rowp = O + (size_t)(row0 + ai * HALF + m * 16) * FF + col0;
                f32x4 v0, v1;
#pragma unroll
                for (int e = 0; e < 4; ++e) { v0[e] = silu_f(acc[ai][0][m][0][e]) * acc[ai][1][m][0][e]; v1[e] = silu_f(acc[ai][0][m][1][e]) * acc[ai][1][m][1][e]; }
                *(u32x4*)rowp = pack8(v0, v1);
            }
    }
};

struct EpiResid {
    static constexpr bool PERM = false, AFTER_DRAIN = false;
    const float* Xp; const float* Xs; float* T; const float* mod; int gate_off; float w;
    __device__ __forceinline__ void operator()(const f32x4 (&acc)[2][2][4][2], const Unit& u, int wr, int wc, int fr, int fq) const {
        const int row0 = u.pm * BM + wr * 64 + fr, col0 = u.pn * BM + wc * 32 + 4 * fq;
#pragma unroll
        for (int ai = 0; ai < 2; ++ai)
#pragma unroll
            for (int m = 0; m < 4; ++m) {
                const int r = row0 + ai * HALF + m * 16;
                const float* gp = mod + (size_t)batch_of_row(r) * NMOD + gate_off + col0;
                const float* xp = (r < MP ? Xp + (size_t)r * DM : Xs + (size_t)(r - MP) * DM) + col0;
                float* tp = T + (size_t)r * DM + col0;
#pragma unroll
                for (int bj = 0; bj < 2; ++bj)
#pragma unroll
                    for (int n = 0; n < 2; ++n) {
                        const int c = bj * HALF + n * 16;
                        const f32x4 g = *(const f32x4*)(gp + c), x = *(const f32x4*)(xp + c);
                        *(f32x4*)(tp + c) = x * ALPHA + (g * w + w) * acc[ai][bj][m][n];
                    }
            }
    }
};

struct EpiMix {
    static constexpr bool PERM = true, AFTER_DRAIN = false;
    bf16_t *RQ, *RK, *RV, *SG, *AQ, *AK, *AV, *IQ, *IKB; float* IWF; float* out; const f32x2* RT1; const f32x2* RT2;
    __device__ __forceinline__ void operator()(const f32x4 (&acc)[2][2][4][2], const Unit& u, int wr, int wc, int fr, int fq) const {
        const int t = u.pn;
        const int row0 = u.pm * BM + wr * 64 + fr;
        if (t < 4) {
            const int head8 = 2 * t + (wc >> 1), j0 = 32 * (wc & 1) + 8 * fq;
            bf16_t* dst = (head8 < 4 ? RQ : RK) + (head8 & 3) * 128 + j0;
            const float sc = head8 < 4 ? 1.f : RK_SCALE;
#pragma unroll
            for (int ai = 0; ai < 2; ++ai)
#pragma unroll
                for (int m = 0; m < 4; ++m) {
                    const int r = row0 + ai * HALF + m * 16, pos = pos_of_row(r);
                    const f32x2* rt = RT1 + (size_t)pos * 64 + j0;
                    f32x4 o1[2], o2[2];
#pragma unroll
                    for (int n = 0; n < 2; ++n) {
                        const f32x4 cs01 = *(const f32x4*)(rt + 4 * n), cs23 = *(const f32x4*)(rt + 4 * n + 2);
                        const float cc[4] = {cs01[0], cs01[2], cs23[0], cs23[2]}, ss[4] = {cs01[1], cs01[3], cs23[1], cs23[3]};
#pragma unroll
                        for (int e = 0; e < 4; ++e) { const float x1 = acc[ai][0][m][n][e], x2 = acc[ai][1][m][n][e];
                            o1[n][e] = (x1 * cc[e] - x2 * ss[e]) * sc; o2[n][e] = (x2 * cc[e] + x1 * ss[e]) * sc; }
                    }
                    bf16_t* p = dst + (size_t)r * 512;
                    *(u32x4*)p = pack8(o1[0], o1[1]); *(u32x4*)(p + 64) = pack8(o2[0], o2[1]);
                }
        } else if (t < 8 || t == 12 || t == 13) {
            bf16_t* dst = (t < 6 ? RV + 256 * (t - 4) : t < 8 ? SG + 256 * (t - 6) : AV + 256 * (t - 12)) + wc * 32 + 8 * fq;
            float* fo = nullptr;
            if (t >= 12) fo = out + (u.pm < 64 ? O_NVP : O_NVS - (size_t)MP * 512) + 256 * (t - 12) + wc * 32 + 8 * fq;
#pragma unroll
            for (int ai = 0; ai < 2; ++ai)
#pragma unroll
                for (int m = 0; m < 4; ++m) {
                    const int r = row0 + ai * HALF + m * 16;
#pragma unroll
                    for (int bj = 0; bj < 2; ++bj) {
                        f32x4 v0 = acc[ai][bj][m][0], v1 = acc[ai][bj][m][1];
                        if (t == 6 || t == 7) {
#pragma unroll
                            for (int e = 0; e < 4; ++e) { v0[e] = silu_f(v0[e]); v1[e] = silu_f(v1[e]); }
                        }
                        *(u32x4*)(dst + (size_t)r * 512 + bj * HALF) = pack8(v0, v1);
                        if (fo) { *(f32x4*)(fo + (size_t)r * 512 + bj * HALF) = v0; *(f32x4*)(fo + (size_t)r * 512 + bj * HALF + 4) = v1; }
                    }
                }
        } else {
            const bool isik = (t == 16);
            if (isik && wc >= 2) return;
            if (isik && wc == 1) {
                if (fq == 0) {
#pragma unroll
                    for (int ai = 0; ai < 2; ++ai)
#pragma unroll
                        for (int m = 0; m < 4; ++m) { const int r = row0 + ai * HALF + m * 16;
                            *(f32x4*)(IWF + (size_t)r * 8) = acc[ai][0][m][0] * IW_SCALE; *(f32x4*)(IWF + (size_t)r * 8 + 4) = acc[ai][0][m][1] * IW_SCALE; }
                }
                return;
            }
            const int head = isik ? 0 : 4 * (t & 1) + wc;
            bf16_t* dst; int pitch; float sc = 1.f; float* fo = nullptr; int fpitch = 512;
            if (t < 10) { dst = AQ; pitch = 512; sc = C2Q; }
            else if (t < 12) { dst = AK; pitch = 512; fo = out + (u.pm < 64 ? O_NKP : O_NKS - (size_t)MP * 512); }
            else if (t < 16) { dst = IQ; pitch = 512; }
            else { dst = IKB; pitch = 64; fo = out + (u.pm < 64 ? O_NIP : O_NIS - (size_t)MP * 64); fpitch = 64; }
            const int d0 = (fq == 0) ? 0 : 16 + 8 * (fq - 1);
            const int d1 = (fq == 0) ? 8 : d0 + 24;
#pragma unroll
            for (int ai = 0; ai < 2; ++ai)
#pragma unroll
                for (int m = 0; m < 4; ++m) {
                    const int r = row0 + ai * HALF + m * 16;
                    f32x4 a0 = acc[ai][0][m][0], a1 = acc[ai][0][m][1], b0 = acc[ai][1][m][0], b1 = acc[ai][1][m][1];
                    if (fq == 0) {
                        const f32x2* rt = RT2 + (size_t)pos_of_row(r) * 8;
                        const f32x4 q0 = *(const f32x4*)(rt), q1 = *(const f32x4*)(rt + 2), q2 = *(const f32x4*)(rt + 4), q3 = *(const f32x4*)(rt + 6);
                        const float cc[8] = {q0[0], q0[2], q1[0], q1[2], q2[0], q2[2], q3[0], q3[2]}, ss[8] = {q0[1], q0[3], q1[1], q1[3], q2[1], q2[3], q3[1], q3[3]};
#pragma unroll
                        for (int e = 0; e < 4; ++e) {
                            const float x1 = a0[e], x2 = b0[e]; a0[e] = x1 * cc[e] - x2 * ss[e]; b0[e] = x2 * cc[e] + x1 * ss[e];
                            const float y1 = a1[e], y2 = b1[e]; a1[e] = y1 * cc[4 + e] - y2 * ss[4 + e]; b1[e] = y2 * cc[4 + e] + y1 * ss[4 + e];
                        }
                    }
                    if (fo) { float* f = fo + (size_t)r * fpitch + head * 64;
                        *(f32x4*)(f + d0) = a0; *(f32x4*)(f + d0 + 4) = a1; *(f32x4*)(f + d1) = b0; *(f32x4*)(f + d1 + 4) = b1; }
                    bf16_t* p = dst + (size_t)r * pitch + head * 64;
                    *(u32x4*)(p + d0) = pack8(a0 * sc, a1 * sc); *(u32x4*)(p + d1) = pack8(b0 * sc, b1 * sc);
                }
        }
    }
};

template <class Epi, class Sched, bool ALIGN_EPI = false, bool SP2 = false>
__device__ __forceinline__ void gemm_phase(PG8_LAS unsigned char* lds, const Gemm g, const Sched& S, const Epi& E) {
    const int tid = threadIdx.x, wid = __builtin_amdgcn_readfirstlane(tid >> 6), lane = tid & 63, wr = wid >> 2, wc = wid & 3, fr = lane & 15, fq = lane >> 4;
    const int K = g.K, nt = K / BK;
    unsigned voffA[2], voffB[2];
#pragma unroll
    for (int i = 0; i < 2; ++i) { int R, C; stage_rc(tid * 16 + i * 8192, R, C); const int Rb = Epi::PERM ? ((R & ~31) + perm32(R & 31)) : R;
        voffA[i] = (unsigned)(R * K + C) * 2u; voffB[i] = (unsigned)(Rb * K + C) * 2u; }
    const size_t kstep = (size_t)(BK * 2);
    const size_t hstep = (size_t)HALF * K * 2;
    const size_t tstep = 2 * hstep;
    const unsigned ldsw = (unsigned)wid * 1024u;
    const int aoff = lds_byte(wr * 64 + fr, fq * 8), boff = lds_byte(wc * 32 + fr, fq * 8);
#define PG8_SA(b, h) (((b) * 2 + (h)) * HTB)
#define PG8_SB(b, h) ((4 + (b) * 2 + (h)) * HTB)
#define PG8_STAGE(bufoff, gbase, voff) do { _Pragma("unroll") for (int _i = 0; _i < 2; ++_i) \
        __builtin_amdgcn_global_load_lds((const unsigned*)((const char*)(gbase) + (voff)[_i]), (PG8_LAS unsigned*)(lds + (bufoff) + ldsw + _i * 8192), 16, 0, 0); } while (0)
#define PG8_LDA(dst, b, h) do { _Pragma("unroll") for (int m = 0; m < 4; ++m) _Pragma("unroll") for (int k = 0; k < 2; ++k) dst[m][k] = *(const PG8_LAS bf16x8*)(lds + PG8_SA(b, h) + aoff + m * 2048 + k * 1024); } while (0)
#define PG8_LDB(dst, b, h) do { _Pragma("unroll") for (int n = 0; n < 2; ++n) _Pragma("unroll") for (int k = 0; k < 2; ++k) dst[n][k] = *(const PG8_LAS bf16x8*)(lds + PG8_SB(b, h) + boff + n * 2048 + k * 1024); } while (0)
#define PG8_MMA(ai, bj, At, Bt) do { __builtin_amdgcn_s_setprio(1); _Pragma("unroll") for (int m = 0; m < 4; ++m) _Pragma("unroll") for (int n = 0; n < 2; ++n) _Pragma("unroll") for (int k = 0; k < 2; ++k) \
        acc[ai][bj][m][n] = __builtin_amdgcn_mfma_f32_16x16x32_bf16(Bt[n][k], At[m][k], acc[ai][bj][m][n], 0, 0, 0); __builtin_amdgcn_s_setprio(0); } while (0)
#define PG8_WAIT_V(n) asm volatile("s_waitcnt vmcnt(" #n ")" ::: "memory")
#define PG8_WAIT_L(n) asm volatile("s_waitcnt lgkmcnt(" #n ")" ::: "memory")
#define PG8_BAR __builtin_amdgcn_s_barrier()
#define PG8_SCHED __builtin_amdgcn_sched_barrier(0)
    Unit cur, nxt; int ui = 0;
    if (!S.next(0, cur)) return;
    f32x4 acc[2][2][4][2];
#pragma unroll
    for (int a = 0; a < 2; ++a)
#pragma unroll
        for (int b = 0; b < 2; ++b)
#pragma unroll
            for (int m = 0; m < 4; ++m)
#pragma unroll
                for (int n = 0; n < 2; ++n) acc[a][b][m][n] = (f32x4){0.f, 0.f, 0.f, 0.f};
    bf16x8 At[4][2], B0[2][2], B1[2][2];
    const char* cA = (const char*)g.A + (size_t)cur.pm * tstep; const char* cB = (const char*)g.Bt + (size_t)cur.pn * tstep;
    S.a_ready(cur);
    if constexpr (SP2) {
        PG8_STAGE(PG8_SB(0, 0), cB, voffB); PG8_STAGE(PG8_SB(0, 1), cB + hstep, voffB); PG8_STAGE(PG8_SA(0, 0), cA, voffA); PG8_STAGE(PG8_SA(0, 1), cA + hstep, voffA);
        if (wr == 1) PG8_BAR;
        PG8_WAIT_V(2); PG8_BAR;
        PG8_STAGE(PG8_SB(1, 0), cB + kstep, voffB); PG8_STAGE(PG8_SA(1, 0), cA + kstep, voffA); PG8_STAGE(PG8_SB(1, 1), cB + hstep + kstep, voffB);
        PG8_WAIT_V(6); PG8_BAR;
    } else {
        PG8_STAGE(PG8_SB(0, 0), cB, voffB); PG8_STAGE(PG8_SA(0, 0), cA, voffA); PG8_STAGE(PG8_SB(0, 1), cB + hstep, voffB); PG8_STAGE(PG8_SA(0, 1), cA + hstep, voffA);
        if (wr == 1) PG8_BAR;
        PG8_WAIT_V(4); PG8_BAR;
        PG8_STAGE(PG8_SB(1, 0), cB + kstep, voffB); PG8_STAGE(PG8_SA(1, 0), cA + kstep, voffA); PG8_STAGE(PG8_SB(1, 1), cB + hstep + kstep, voffB);
        PG8_WAIT_V(6); PG8_BAR;
    }
    for (;;) {
        const bool has_next = S.next(ui + 1, nxt);
        const char* nA = has_next ? (const char*)g.A + (size_t)nxt.pm * tstep : cA; const char* nB = has_next ? (const char*)g.Bt + (size_t)nxt.pn * tstep : cB;
        for (int t = 0; t < nt; t += 2) {
            const bool last = (t == nt - 2);
            const char* a1 = cA + (size_t)(t + 1) * kstep;
            const char* a2 = last ? nA : cA + (size_t)(t + 2) * kstep; const char* b2 = last ? nB : cB + (size_t)(t + 2) * kstep;
            const char* a3 = a2 + kstep; const char* b3 = b2 + kstep;
            if (last && has_next) S.a_ready(nxt);
            if constexpr (SP2) {
            PG8_LDB(B0, 0, 0); PG8_LDB(B1, 0, 1); PG8_SCHED; PG8_LDA(At, 0, 0); PG8_STAGE(PG8_SA(1, 1), a1 + hstep, voffA);
            PG8_WAIT_V(8); PG8_WAIT_L(0); PG8_BAR; PG8_MMA(0, 0, At, B0); PG8_MMA(0, 1, At, B1); PG8_BAR; PG8_SCHED;
            PG8_LDA(At, 0, 1); PG8_STAGE(PG8_SB(0, 0), b2, voffB); PG8_STAGE(PG8_SB(0, 1), b2 + hstep, voffB); PG8_STAGE(PG8_SA(0, 0), a2, voffA);
            PG8_WAIT_V(8); PG8_WAIT_L(0); PG8_BAR; PG8_MMA(1, 0, At, B0); PG8_MMA(1, 1, At, B1); PG8_BAR; PG8_SCHED;
            PG8_LDB(B0, 1, 0); PG8_LDB(B1, 1, 1); PG8_SCHED; PG8_LDA(At, 1, 0); PG8_STAGE(PG8_SA(0, 1), a2 + hstep, voffA);
            PG8_WAIT_V(8); PG8_WAIT_L(0); PG8_BAR; PG8_MMA(0, 0, At, B0); PG8_MMA(0, 1, At, B1); PG8_BAR; PG8_SCHED;
            PG8_LDA(At, 1, 1); PG8_STAGE(PG8_SB(1, 0), b3, voffB); PG8_STAGE(PG8_SB(1, 1), b3 + hstep, voffB); PG8_STAGE(PG8_SA(1, 0), a3, voffA);
            PG8_WAIT_V(8); PG8_WAIT_L(0); PG8_BAR; PG8_MMA(1, 0, At, B0); PG8_MMA(1, 1, At, B1); PG8_BAR; PG8_SCHED;
            } else {
            PG8_LDB(B0, 0, 0); PG8_SCHED; PG8_LDA(At, 0, 0); PG8_STAGE(PG8_SA(1, 1), a1 + hstep, voffA);
            PG8_WAIT_L(8); PG8_BAR; PG8_WAIT_L(0); PG8_MMA(0, 0, At, B0); PG8_BAR; PG8_SCHED;
            PG8_LDB(B1, 0, 1); PG8_STAGE(PG8_SB(0, 0), b2, voffB);
            PG8_BAR; PG8_WAIT_L(0); PG8_MMA(0, 1, At, B1); PG8_BAR;
            PG8_LDA(At, 0, 1); PG8_STAGE(PG8_SA(0, 0), a2, voffA);
            PG8_BAR; PG8_WAIT_L(0); PG8_MMA(1, 0, At, B0); PG8_BAR; PG8_SCHED;
            PG8_STAGE(PG8_SB(0, 1), b2 + hstep, voffB);
            PG8_WAIT_V(6); PG8_BAR; PG8_MMA(1, 1, At, B1); PG8_BAR;
            PG8_LDB(B0, 1, 0); PG8_SCHED; PG8_LDA(At, 1, 0); PG8_STAGE(PG8_SA(0, 1), a2 + hstep, voffA);
            PG8_WAIT_L(8); PG8_BAR; PG8_WAIT_L(0); PG8_MMA(0, 0, At, B0); PG8_BAR; PG8_SCHED;
            PG8_LDB(B1, 1, 1); PG8_STAGE(PG8_SB(1, 0), b3, voffB);
            PG8_BAR; PG8_WAIT_L(0); PG8_MMA(0, 1, At, B1); PG8_BAR;
            PG8_LDA(At, 1, 1); PG8_STAGE(PG8_SA(1, 0), a3, voffA);
            PG8_BAR; PG8_WAIT_L(0); PG8_MMA(1, 0, At, B0); PG8_BAR; PG8_SCHED;
            PG8_STAGE(PG8_SB(1, 1), b3 + hstep, voffB);
            PG8_WAIT_V(6); PG8_BAR; PG8_MMA(1, 1, At, B1); PG8_BAR;
            }
        }
        if constexpr (ALIGN_EPI) { if (wr == 0) PG8_BAR; }
        if constexpr (!Epi::AFTER_DRAIN) { E(acc, cur, wr, wc, fr, fq); S.done(cur); }
        if (!has_next) break;
#pragma unroll
        for (int a = 0; a < 2; ++a)
#pragma unroll
            for (int b = 0; b < 2; ++b)
#pragma unroll
                for (int m = 0; m < 4; ++m)
#pragma unroll
                    for (int n = 0; n < 2; ++n) acc[a][b][m][n] = (f32x4){0.f, 0.f, 0.f, 0.f};
        cur = nxt; cA = nA; cB = nB; ++ui;
        if constexpr (ALIGN_EPI) { if (wr == 1) PG8_BAR; }
    }
    PG8_WAIT_V(0);
    if constexpr (!ALIGN_EPI) { if (wr == 0) PG8_BAR; }
    PG8_BAR;
    if constexpr (Epi::AFTER_DRAIN) { E.fused(acc, cur, wr, wc, fr, fq, lds, wid, lane); S.done(cur); }
#undef PG8_SA
#undef PG8_SB
#undef PG8_STAGE
#undef PG8_LDA
#undef PG8_LDB
#undef PG8_MMA
#undef PG8_WAIT_V
#undef PG8_WAIT_L
#undef PG8_BAR
#undef PG8_SCHED
}
}

constexpr int NWAVES = 8;
#ifndef MK_N_LAUNCHES
#define MK_N_LAUNCHES 1
#endif
constexpr int NPHASE = 13;
constexpr int N_LAUNCHES = MK_N_LAUNCHES;

constexpr size_t MiB = 1u << 20;
constexpr size_t WS_CTL = 0, CTL_ZERO_BYTES = 1 * MiB;
constexpr size_t WS_MOD = 1 * MiB;
constexpr size_t WS_RT1 = 3 * MiB;
constexpr size_t WS_RT2 = 4 * MiB + 512 * 1024;
constexpr size_t WS_IWF = 5 * MiB;
constexpr size_t WS_WGU1 = 6 * MiB, WS_WD1 = 17 * MiB, WS_WIN = 23 * MiB, WS_WOUT = 32 * MiB, WS_WGU2 = 34 * MiB, WS_WD2 = 45 * MiB;
constexpr size_t WS_IKB = 51 * MiB;
constexpr size_t WS_MASK = 54 * MiB;
constexpr size_t WS_H = 64 * MiB;
constexpr size_t WS_XT = 98 * MiB;
constexpr size_t WS_ACT = 166 * MiB;
constexpr size_t WS_RQ = 166 * MiB, WS_RK = 183 * MiB, WS_RV = 200 * MiB, WS_SG = 217 * MiB, WS_AQ = 234 * MiB, WS_AK = 251 * MiB, WS_AV = 268 * MiB, WS_IQ = 285 * MiB;
constexpr size_t WS_END = 302 * MiB;
constexpr int MASKP = 36;
static_assert(WS_ACT + (size_t)MROWS * FF * 2 <= 260 * MiB && WS_IQ + (size_t)MROWS * 512 * 2 <= WS_END && WS_XT + (size_t)MROWS * DM * 4 <= WS_ACT && WS_H + (size_t)MROWS * DM * 2 <= WS_XT, "d_ws map");
static_assert(WS_MASK + (size_t)MROWS * MASKP * 8 <= WS_H && WS_WD2 + (size_t)DM * FF * 2 <= WS_IKB && WS_MOD + 40 * NMOD * 4 <= WS_RT1 && WS_RT1 + 2080 * 64 * 8 <= WS_RT2 && WS_RT2 + 2080 * 8 * 8 <= WS_IWF && WS_IWF + (size_t)MROWS * 32 <= WS_WGU1, "d_ws map 2");
constexpr int CW_TMO = 0, CW_CODE = 1;
constexpr int CW_TICKET = 64;
constexpr int CW_BAR = 4096;
constexpr int LDS_BYTES = 147456;
constexpr int MISC_OFF = LDS_BYTES - 128;
constexpr int RING_BYTES = 131072;

#define GAS __attribute__((address_space(1)))
#define LAS __attribute__((address_space(3)))
typedef unsigned short bf16;
typedef unsigned v4u __attribute__((ext_vector_type(4)));
typedef unsigned v2u __attribute__((ext_vector_type(2)));
typedef float f32x4 __attribute__((ext_vector_type(4)));
typedef float f32x2 __attribute__((ext_vector_type(2)));
typedef float f32x16 __attribute__((ext_vector_type(16)));
typedef short bf16x8 __attribute__((ext_vector_type(8)));
typedef short bf16x4 __attribute__((ext_vector_type(4)));
typedef GAS unsigned gu32;
typedef GAS unsigned long long gu64;
#define RLX_AGENT __ATOMIC_RELAXED, __HIP_MEMORY_SCOPE_AGENT
#define LDS_WAIT() asm volatile("s_waitcnt lgkmcnt(0)" ::: "memory")
#define VM_WAIT() asm volatile("s_waitcnt vmcnt(0)" ::: "memory")
__device__ __forceinline__ unsigned f2bf(float f) { unsigned u = __builtin_bit_cast(unsigned, f); return (u + 0x7fffu + ((u >> 16) & 1u)) >> 16; }
__device__ __forceinline__ unsigned pk2(float lo, float hi) { return f2bf(lo) | (f2bf(hi) << 16); }
__device__ __forceinline__ float bf2f(unsigned short b) { return __builtin_bit_cast(float, (unsigned)b << 16); }
__device__ __forceinline__ float bflo(unsigned w) { return __builtin_bit_cast(float, w << 16); }
__device__ __forceinline__ float bfhi(unsigned w) { return __builtin_bit_cast(float, w & 0xffff0000u); }
using pg8::batch_of_row; using pg8::pos_of_row; using pg8::silu_f;
#define XB_TMO      128
#define XB_XCNT(j)  (256  + 64 * (j))
#define XB_XSUB(j)  (1280 + 64 * (j))
#define XB_XGEN(j)  (2304 + 64 * (j))
#define XB_TOP      3328
#define XB_TOPGEN   3392
#define XCD_BAR_WORDS 3456
#define XB_SPIN_CAP (1u << 18)

__device__ __forceinline__ unsigned xb_ld(unsigned* p)              { return __hip_atomic_load(p, __ATOMIC_RELAXED, __HIP_MEMORY_SCOPE_AGENT); }
__device__ __forceinline__ unsigned xb_add(unsigned* p, unsigned v) { return __hip_atomic_fetch_add(p, v, __ATOMIC_RELAXED, __HIP_MEMORY_SCOPE_AGENT); }
__device__ __forceinline__ unsigned xb_xcc_id() { return (unsigned)__builtin_amdgcn_s_getreg((3 << 11) | 20) & 0xFu; }
#define XB_SPIN(cond, bar) do { unsigned _sp = 0; while (cond) { __builtin_amdgcn_s_sleep(1); \
    if ((++_sp & 255u) == 0u) { if (xb_ld(&(bar)[XB_TMO])) break; if (_sp > XB_SPIN_CAP) { atomicAdd(&(bar)[XB_TMO], 1u); break; } } } } while (0)

struct XcdBarrier {
    unsigned* bar; unsigned x;
    volatile LAS unsigned* st;
};

__device__ __forceinline__ XcdBarrier xcd_barrier_post(unsigned* bar, volatile LAS unsigned* st) {
    XcdBarrier b; b.bar = bar; b.x = xb_xcc_id(); b.st = st;
    if (threadIdx.x == 0) (void)xb_add(&bar[XB_XCNT(b.x)], 1u);
    return b;
}
__device__ __forceinline__ void xcd_barrier_complete(unsigned* bar, unsigned x, unsigned& nloc, unsigned& nx) {
    const unsigned G = gridDim.x * gridDim.y * gridDim.z;
    unsigned sum, cnt, mine, sp = 0u;
    for (;;) {
        sum = 0u; cnt = 0u; mine = 0u;
#pragma unroll
        for (unsigned j = 0; j < 16; ++j) { const unsigned c = xb_ld(&bar[XB_XCNT(j)]); sum += c; cnt += (c > 0u) ? 1u : 0u; mine = (j == x) ? c : mine; }
        if (sum == G) break;
        __builtin_amdgcn_s_sleep(1);
        if ((++sp & 255u) == 0u) { if (xb_ld(&bar[XB_TMO])) break; if (sp > XB_SPIN_CAP) { atomicAdd(&bar[XB_TMO], 1u); break; } }
    }
    nloc = mine > 0u ? mine : 1u; nx = cnt > 0u ? cnt : 1u;
}

__device__ __forceinline__ void xcd_barrier(const XcdBarrier& b) {
    asm volatile("s_waitcnt vmcnt(0)" ::: "memory");
    __syncthreads();
    if (threadIdx.x == 0) {
        unsigned* bar = b.bar;
        __builtin_amdgcn_s_waitcnt(0);
        unsigned nloc = b.st[0], nx = b.st[1];
        if (nloc == 0u) { xcd_barrier_complete(bar, b.x, nloc, nx); b.st[0] = nloc; b.st[1] = nx; }
        const unsigned old = xb_add(&bar[XB_XSUB(b.x)], 1u);
        const unsigned gen = old / nloc;
        if (old + 1u == (gen + 1u) * nloc) {
            __builtin_amdgcn_fence(__ATOMIC_RELEASE, "agent");
            asm volatile("s_waitcnt vmcnt(0)" ::: "memory");
            const unsigned og = xb_add(&bar[XB_TOP], 1u);
            const unsigned tg = og / nx;
            if (og + 1u == (tg + 1u) * nx) xb_add(&bar[XB_TOPGEN], 1u);
            else XB_SPIN(xb_ld(&bar[XB_TOPGEN]) == tg, bar);
            __builtin_amdgcn_fence(__ATOMIC_ACQUIRE, "agent");
            xb_add(&bar[XB_XGEN(b.x)], 1u);
            asm volatile("s_waitcnt vmcnt(0)" ::: "memory");
        } else {
            XB_SPIN(xb_ld(&bar[XB_XGEN(b.x)]) == gen, bar);
            __builtin_amdgcn_fence(__ATOMIC_ACQUIRE, "agent");
            asm volatile("s_waitcnt vmcnt(0)" ::: "memory");
        }
    }
    __syncthreads();
}

struct Args { const float* in[24]; float* out; unsigned char* ws; int ph_lo, ph_hi, li, pad; };
struct Frame {
    LAS unsigned char* lds;
    volatile LAS unsigned* MISC;
    const Args* a; unsigned char* ws;
    int tid, lane, wave, vcu, G;
    __device__ __forceinline__ gu32* ctl() const { return (gu32*)(ws + WS_CTL); }
    __device__ __forceinline__ float* out() const { return a->out; }
    __device__ __forceinline__ float* MOD() const { return (float*)(ws + WS_MOD); }
    __device__ __forceinline__ float* IWF() const { return (float*)(ws + WS_IWF); }
    __device__ __forceinline__ float* XT() const { return (float*)(ws + WS_XT); }
    __device__ __forceinline__ f32x2* RT1() const { return (f32x2*)(ws + WS_RT1); }
    __device__ __forceinline__ f32x2* RT2() const { return (f32x2*)(ws + WS_RT2); }
    __device__ __forceinline__ bf16* WGU1() const { return (bf16*)(ws + WS_WGU1); }
    __device__ __forceinline__ bf16* WD1() const { return (bf16*)(ws + WS_WD1); }
    __device__ __forceinline__ bf16* WIN() const { return (bf16*)(ws + WS_WIN); }
    __device__ __forceinline__ bf16* WOUT() const { return (bf16*)(ws + WS_WOUT); }
    __device__ __forceinline__ bf16* WGU2() const { return (bf16*)(ws + WS_WGU2); }
    __device__ __forceinline__ bf16* WD2() const { return (bf16*)(ws + WS_WD2); }
    __device__ __forceinline__ bf16* H() const { return (bf16*)(ws + WS_H); }
    __device__ __forceinline__ bf16* ACT() const { return (bf16*)(ws + WS_ACT); }
    __device__ __forceinline__ bf16* RQ() const { return (bf16*)(ws + WS_RQ); }
    __device__ __forceinline__ bf16* RK() const { return (bf16*)(ws + WS_RK); }
    __device__ __forceinline__ bf16* RV() const { return (bf16*)(ws + WS_RV); }
    __device__ __forceinline__ bf16* SG() const { return (bf16*)(ws + WS_SG); }
    __device__ __forceinline__ bf16* AQ() const { return (bf16*)(ws + WS_AQ); }
    __device__ __forceinline__ bf16* AK() const { return (bf16*)(ws + WS_AK); }
    __device__ __forceinline__ bf16* AV() const { return (bf16*)(ws + WS_AV); }
    __device__ __forceinline__ bf16* IQ() const { return (bf16*)(ws + WS_IQ); }
    __device__ __forceinline__ bf16* IKB() const { return (bf16*)(ws + WS_IKB); }
    __device__ __forceinline__ unsigned long long* MASK() const { return (unsigned long long*)(ws + WS_MASK); }
    __device__ __forceinline__ const float* xp() const { return a->in[0]; }
    __device__ __forceinline__ const float* xs() const { return a->in[1]; }
    __device__ __forceinline__ const float* cp() const { return a->in[2]; }
    __device__ __forceinline__ const float* cs() const { return a->in[3]; }
    __device__ __forceinline__ const float* cache_k() const { return a->in[4]; }
    __device__ __forceinline__ const float* cache_v() const { return a->in[5]; }
    __device__ __forceinline__ const float* cache_ik() const { return a->in[6]; }
    __device__ __forceinline__ const float* state_ret() const { return a->in[7]; }
    __device__ __forceinline__ const float* w_cond() const { return a->in[8]; }
    __device__ __forceinline__ const float* b_cond() const { return a->in[9]; }
    __device__ __forceinline__ const float* f1g() const { return a->in[10]; }
    __device__ __forceinline__ const float* f1u() const { return a->in[11]; }
    __device__ __forceinline__ const float* f1d() const { return a->in[12]; }
    __device__ __forceinline__ const float* ln1g() const { return a->in[13]; }
    __device__ __forceinline__ const float* ln1b() const { return a->in[14]; }
    __device__ __forceinline__ const float* w_in() const { return a->in[15]; }
    __device__ __forceinline__ const float* w_out() const { return a->in[16]; }
    __device__ __forceinline__ const float* ln2g() const { return a->in[17]; }
    __device__ __forceinline__ const float* ln2b() const { return a->in[18]; }
    __device__ __forceinline__ const float* f2g() const { return a->in[19]; }
    __device__ __forceinline__ const float* f2u() const { return a->in[20]; }
    __device__ __forceinline__ const float* f2d() const { return a->in[21]; }
    __device__ __forceinline__ const float* ln3g() const { return a->in[22]; }
    __device__ __forceinline__ const float* ln3b() const { return a->in[23]; }
};
__device__ __forceinline__ float wave_sum(float v) {
#pragma unroll
    for (int o = 1; o < 64; o <<= 1) v += __shfl_xor(v, o);
    return v;
}
__device__ __forceinline__ int wave_sum_i(int v) {
#pragma unroll
    for (int o = 1; o < 64; o <<= 1) v += __shfl_xor(v, o);
    return v;
}
__device__ __forceinline__ int next_ticket(Frame& F, int q) {
    __syncthreads();
    if (F.tid == 0) F.MISC[4] = __hip_atomic_fetch_add(F.ctl() + CW_TICKET + 64 * q, 1u, RLX_AGENT);
    __syncthreads();
    return (int)F.MISC[4];
}

struct SrcGU { const float* Wg; const float* Wu; __device__ __forceinline__ const float* operator()(int R) const { const int pn = R >> 8, c = R & 255; const uintptr_t a = (uintptr_t)Wg, b = (uintptr_t)Wu, m = (uintptr_t)0 - (uintptr_t)(c >= 128); return (const float*)((a & ~m) | (b & m)) + (pn * 128 + (c & 127)); } };
struct SrcPlain { const float* W; __device__ __forceinline__ const float* operator()(int R) const { return W + R; } };
__device__ __forceinline__ int rot_dim(int bj, int g) { const int fq = g >> 3, i = g & 7; return fq == 0 ? 8 * bj + i : 16 + 24 * bj + 8 * (fq - 1) + i; }
struct SrcWin { const float* W;
    __device__ __forceinline__ const float* operator()(int R) const {
        const int t = R >> 8, c = R & 255, bj = c >> 7, cc = c & 127; int col;
        if (t < 4) { const int head8 = 2 * t + (cc >> 6); col = head8 * 128 + (cc & 63) + 64 * bj; }
        else if (t < 6) col = 1024 + 256 * (t - 4) + c;
        else if (t < 8) col = 1536 + 256 * (t - 6) + c;
        else if (t == 12 || t == 13) col = 3072 + 256 * (t - 12) + c;
        else if (t < 16) { const int base = t < 10 ? 2048 : t < 12 ? 2560 : 3584; col = base + (4 * (t & 1) + (cc >> 5)) * 64 + rot_dim(bj, cc & 31); }
        else { const int hh = cc >> 5, g = cc & 31;
            if (hh == 0) col = 4096 + rot_dim(bj, g);
            else if (hh == 1 && bj == 0 && g < 8) col = 4160 + g;
            else return nullptr; }
        return W + col;
    }
};
template <class Src> __device__ __forceinline__ void p0_item(const Src& src, int N, int K, bf16* WT, LAS float* scr, int item, int lane) {
    const int nkb = K / 64, nb = item / nkb, kb = item % nkb, k0 = 64 * kb, n0 = 32 * nb;
    const float* cp = src(n0 + (lane & 31));
#pragma unroll 8
    for (int i = 0; i < 32; ++i) { const int kk = 2 * i + (lane >> 5); scr[kk * 33 + (lane & 31)] = cp ? cp[(size_t)(k0 + kk) * N] : 0.f; }
    LDS_WAIT(); asm volatile("" ::: "memory");
    const int c = lane & 7;
#pragma unroll
    for (int j = 0; j < 4; ++j) { const int n = (lane >> 3) + 8 * j; const LAS float* s = scr + (8 * c) * 33 + n;
        v4u o; o.x = pk2(s[0 * 33], s[1 * 33]); o.y = pk2(s[2 * 33], s[3 * 33]); o.z = pk2(s[4 * 33], s[5 * 33]); o.w = pk2(s[6 * 33], s[7 * 33]);
        *(GAS v4u*)(WT + (size_t)(n0 + n) * K + k0 + 8 * c) = o; }
    LDS_WAIT(); asm volatile("" ::: "memory");
}
__device__ const double INVREV1[64] = {0.15915494309189535, 0.13782250260398285, 0.11934937021124886, 0.10335229661843406, 0.08949940160889101, 0.07750328875537406, 0.06711508300522726, 0.058119267441876246, 0.050329212104487035, 0.04358330210530733, 0.03774158471741977, 0.032682865872357, 0.0283021958306234, 0.024508691862069852, 0.02122365276477766, 0.018378926105679667, 0.015915494309189534, 0.013782250260398284, 0.011934937021124886, 0.010335229661843406, 0.008949940160889102, 0.0077503288755374055, 0.006711508300522725, 0.005811926744187624, 0.005032921210448704, 0.004358330210530733, 0.003774158471741977, 0.0032682865872356993, 0.00283021958306234, 0.002450869186206985, 0.0021223652764777662, 0.0018378926105679667, 0.0015915494309189536, 0.0013782250260398288, 0.0011934937021124885, 0.0010335229661843405, 0.0008949940160889102, 0.0007750328875537405, 0.0006711508300522726, 0.0005811926744187624, 0.0005032921210448703, 0.0004358330210530733, 0.00037741584717419774, 0.0003268286587235699, 0.00028302195830623395, 0.00024508691862069854, 0.0002122365276477766, 0.00018378926105679666, 0.00015915494309189535, 0.00013782250260398286, 0.00011934937021124886, 0.00010335229661843406, 8.949940160889102e-05, 7.750328875537406e-05, 6.711508300522725e-05, 5.811926744187624e-05, 5.0329212104487035e-05, 4.358330210530732e-05, 3.774158471741978e-05, 3.2682865872357e-05, 2.8302195830623396e-05, 2.4508691862069852e-05, 2.122365276477766e-05, 1.8378926105679668e-05};
__device__ const double INVREV2[8] = {0.15915494309189535, 0.03086376340470123, 0.005985185712713705, 0.001160663641240061, 0.00022507907903927653, 4.364795279280289e-05, 8.464330808241401e-06, 1.6414262627950345e-06};

__device__ __forceinline__ void p0_prologue(Frame& F) {
    for (int chunk = blockIdx.x; chunk < NMOD / 64; chunk += F.G) {
        LAS float* sw = (LAS float*)(F.lds) + F.wave * (40 * 64);
        const int n = chunk * 64 + F.lane;
        float acc[40];
#pragma unroll
        for (int b = 0; b < 40; ++b) acc[b] = 0.f;
        for (int sub = 0; sub < 2; ++sub) {
            const int kb = F.wave * 128 + sub * 64;
#pragma unroll 8
            for (int b = 0; b < 40; ++b) { const float c = (b < 8 ? F.cp() + b * DM : F.cs() + (b - 8) * DM)[kb + F.lane]; sw[b * 64 + F.lane] = silu_f(c); }
            LDS_WAIT(); asm volatile("" ::: "memory");
            for (int kk = 0; kk < 64; kk += 4) {
                const float* wp = F.w_cond() + (size_t)(kb + kk) * NMOD + n;
                const float w0 = wp[0], w1 = wp[NMOD], w2 = wp[2 * NMOD], w3 = wp[3 * NMOD];
#pragma unroll
                for (int b = 0; b < 40; ++b) { const f32x4 s = *(const LAS f32x4*)(sw + b * 64 + kk); acc[b] += s[0] * w0 + s[1] * w1 + s[2] * w2 + s[3] * w3; }
            }
            LDS_WAIT(); asm volatile("" ::: "memory");
        }
        __syncthreads();
        LAS float* red = (LAS float*)(F.lds);
#pragma unroll
        for (int b = 0; b < 40; ++b) red[(F.wave * 40 + b) * 64 + F.lane] = acc[b];
        __syncthreads();
        for (int o = F.tid; o < 40 * 64; o += NWAVES * 64) { const int b = o >> 6, nl = o & 63; float s = 0.f;
#pragma unroll
            for (int w = 0; w < 8; ++w) s += red[(w * 40 + b) * 64 + nl];
            F.MOD()[(size_t)b * NMOD + chunk * 64 + nl] = s + F.b_cond()[chunk * 64 + nl]; }
        __syncthreads();
    }
    { const int gt = F.vcu * (NWAVES * 64) + F.tid, NT = F.G * NWAVES * 64;
        for (int i = gt; i < 2080 * 64; i += NT) { const int pos = i >> 6, j = i & 63; const double rv = (double)pos * INVREV1[j]; const float fr = (float)(rv - __builtin_floor(rv));
            F.RT1()[i] = (f32x2){__builtin_amdgcn_cosf(fr), __builtin_amdgcn_sinf(fr)}; }
        for (int i = gt; i < 2080 * 8; i += NT) { const int pos = i >> 3, j = i & 7; const double rv = (double)pos * INVREV2[j]; const float fr = (float)(rv - __builtin_floor(rv));
            F.RT2()[i] = (f32x2){__builtin_amdgcn_cosf(fr), __builtin_amdgcn_sinf(fr)}; }
    }
    LAS float* scr = (LAS float*)(F.lds + F.wave * 16384);
    const int gw = F.vcu * NWAVES + F.wave, NGW = F.G * NWAVES;
    constexpr int I_GU = (NGU / 32) * (DM / 64), I_D = (DM / 32) * (FF / 64), I_IN = (NIN / 32) * (DM / 64), I_O = (DM / 32) * (DM / 64);
    constexpr int NITEMS = 2 * I_GU + 2 * I_D + I_IN + I_O;
    for (int it = gw; it < NITEMS; it += NGW) {
        int r = it;
        if (r < I_GU) { p0_item(SrcGU{F.f1g(), F.f1u()}, FF, DM, F.WGU1(), scr, r, F.lane); continue; } r -= I_GU;
        if (r < I_GU) { p0_item(SrcGU{F.f2g(), F.f2u()}, FF, DM, F.WGU2(), scr, r, F.lane); continue; } r -= I_GU;
        if (r < I_D) { p0_item(SrcPlain{F.f1d()}, DM, FF, F.WD1(), scr, r, F.lane); continue; } r -= I_D;
        if (r < I_D) { p0_item(SrcPlain{F.f2d()}, DM, FF, F.WD2(), scr, r, F.lane); continue; } r -= I_D;
        if (r < I_IN) { p0_item(SrcWin{F.w_in()}, DIN, DM, F.WIN(), scr, r, F.lane); continue; } r -= I_IN;
        p0_item(SrcPlain{F.w_out()}, DM, DM, F.WOUT(), scr, r, F.lane);
    }
}
__device__ __forceinline__ const float* xrow(const Frame& F, int m) { return m < MP ? F.xp() + (size_t)m * DM : F.xs() + (size_t)(m - MP) * DM; }
__device__ __forceinline__ void p1_modulate(Frame& F) {
    const int gw = F.vcu * NWAVES + F.wave, NGW = F.G * NWAVES;
    for (int m = gw; m < MROWS; m += NGW) {
        const GAS f32x4* xr = (const GAS f32x4*)xrow(F, m) + F.lane;
        const float* mp = F.MOD() + (size_t)batch_of_row(m) * NMOD;
        GAS unsigned long long* o8 = (GAS unsigned long long*)(F.H() + (size_t)m * DM) + F.lane;
#pragma unroll
        for (int j = 0; j < 4; ++j) { const f32x4 v = xr[64 * j]; const int c = 4 * F.lane + 256 * j;
            const f32x4 sh = *(const f32x4*)(mp + c), sc = *(const f32x4*)(mp + DM + c); const f32x4 h = v * (sc + 1.f) + sh;
            o8[64 * j] = (unsigned long long)pk2(h[0], h[1]) | ((unsigned long long)pk2(h[2], h[3]) << 32); }
    }
}
__device__ __forceinline__ void ln_pass(Frame& F, const float* Tin, float* Xout, bf16* Hout, const float* g, const float* b, int moff) {
    const int gw = F.vcu * NWAVES + F.wave, NGW = F.G * NWAVES;
    for (int m = gw; m < MROWS; m += NGW) {
        const GAS f32x4* xr = (const GAS f32x4*)(Tin + (size_t)m * DM) + F.lane;
        f32x4 v[4]; float s = 0.f;
#pragma unroll
        for (int j = 0; j < 4; ++j) { v[j] = xr[64 * j]; s += (v[j][0] + v[j][1]) + (v[j][2] + v[j][3]); }
        const float mean = wave_sum(s) * (1.f / DM); float s2 = 0.f;
#pragma unroll
        for (int j = 0; j < 4; ++j) { v[j] = v[j] - mean; s2 += (v[j][0] * v[j][0] + v[j][1] * v[j][1]) + (v[j][2] * v[j][2] + v[j][3] * v[j][3]); }
        const float rstd = 1.f / sqrtf(wave_sum(s2) * (1.f / DM) + LN_EPS);
        const float* mp = F.MOD() + (size_t)batch_of_row(m) * NMOD + moff;
        GAS f32x4* xo = (GAS f32x4*)(Xout + (size_t)m * DM) + F.lane;
#pragma unroll
        for (int j = 0; j < 4; ++j) { const int c = 4 * F.lane + 256 * j;
            const f32x4 y = v[j] * rstd * *(const f32x4*)(g + c) + *(const f32x4*)(b + c);
            xo[64 * j] = y;
            if (Hout) { const f32x4 sh = *(const f32x4*)(mp + c), sc = *(const f32x4*)(mp + DM + c); const f32x4 h = y * (sc + 1.f) + sh;
                ((GAS unsigned long long*)(Hout + (size_t)m * DM) + F.lane)[64 * j] = (unsigned long long)pk2(h[0], h[1]) | ((unsigned long long)pk2(h[2], h[3]) << 32); }
        }
    }
}


constexpr int RT_Q = 0, RT_K = 17408, RT_KT = 34816, RT_VT = 53248, RT_SC = 71680, RT_ST = 80896, RT_STATS = 115712, RT_ROW = 119808, RT_END = 120320;
template <int C> __device__ __forceinline__ void ret_unit(Frame& F, int rowbase, int nchunks, int h, const float* S0, float* Sout) {
    constexpr int NR = C / 16, KS = C / 32, NP = C / 32;
    const int tid = F.tid, lane = F.lane, w = F.wave, fr = lane & 15, fq = lane >> 4;
    LAS unsigned char* L = F.lds;
    const float lg2g = log2f(1.f - exp2f(-5.f - (float)h));
    const float gC = exp2f(lg2g * (float)C);
    f32x4 S[8];
    asm volatile("" : "+s"(nchunks));
    if (S0) {
#pragma unroll 2
        for (int i = 0; i < 8; ++i) *(LAS f32x4*)(L + (tid + 512 * i) * 16) = *(const GAS f32x4*)(S0 + (size_t)(tid + 512 * i) * 4);
        __syncthreads();
    }
#pragma unroll
    for (int T = 0; T < 8; ++T) {
        if (S0) {
#pragma unroll
            for (int i = 0; i < 4; ++i) S[T][i] = *(const LAS float*)(L + ((16 * T + 4 * fq + i) * 128 + 16 * w + fr) * 4);
        } else S[T] = (f32x4){0.f, 0.f, 0.f, 0.f};
        *(LAS v2u*)(L + RT_ST + (16 * w + fr) * 272 + (16 * T + 4 * fq) * 2) = (v2u){pk2(S[T][0], S[T][1]), pk2(S[T][2], S[T][3])};
    }
    v4u qreg[NP], kreg[NP], vreg[NP];
#define RET_ISSUE(c_) do { _Pragma("unroll") for (int p = 0; p < NP; ++p) { const int idx = tid + 512 * p, row = idx >> 4, col = (idx & 15) * 8; const size_t off = (size_t)(rowbase + C * (c_) + row) * 512 + h * 128 + col; \
            qreg[p] = *(const GAS v4u*)(F.RQ() + off); kreg[p] = *(const GAS v4u*)(F.RK() + off); vreg[p] = *(const GAS v4u*)(F.RV() + off); } } while (0)
    RET_ISSUE(0);
    f32x4 o[NR];
    __syncthreads();
    for (int c = 0; c <= nchunks; ++c) {
        int fqo = fq, fro = fr; asm volatile("" : "+v"(fqo), "+v"(fro));
        if (c < nchunks) {
#pragma unroll
            for (int p = 0; p < NP; ++p) { const int idx = tid + 512 * p, row = idx >> 4, col = (idx & 15) * 8;
                *(LAS v4u*)(L + RT_Q + row * 272 + col * 2) = qreg[p];
                *(LAS v4u*)(L + RT_K + row * 272 + col * 2) = kreg[p];
                const float dk = exp2f(lg2g * (float)(C - 1 - row));
#pragma unroll
                for (int jj = 0; jj < 4; ++jj) { const unsigned kw = kreg[p][jj], vw = vreg[p][jj];
                    *(LAS unsigned short*)(L + RT_KT + (col + 2 * jj) * 144 + row * 2) = (unsigned short)f2bf(bflo(kw) * dk);
                    *(LAS unsigned short*)(L + RT_KT + (col + 2 * jj + 1) * 144 + row * 2) = (unsigned short)f2bf(bfhi(kw) * dk);
                    *(LAS unsigned short*)(L + RT_VT + (col + 2 * jj) * 144 + row * 2) = (unsigned short)(vw & 0xffffu);
                    *(LAS unsigned short*)(L + RT_VT + (col + 2 * jj + 1) * 144 + row * 2) = (unsigned short)(vw >> 16); }
            }
            if (c + 1 < nchunks) RET_ISSUE(c + 1);
        }
        if (c > 0 && tid < C) {
            const LAS f32x2* st = (const LAS f32x2*)(L + RT_STATS) + tid * 8; float mt = 0.f; f32x2 e[8];
#pragma unroll
            for (int k = 0; k < 8; ++k) { e[k] = st[k]; mt += e[k][0]; }
            mt *= 0.125f; float m2 = 0.f;
#pragma unroll
            for (int k = 0; k < 8; ++k) { const float dm = e[k][0] - mt; m2 += e[k][1] + 16.f * dm * dm; }
            ((LAS f32x2*)(L + RT_ROW))[tid] = (f32x2){mt, 1.f / sqrtf(m2 * (1.f / 128.f) + LN_EPS)};
        }
        __syncthreads();
        if (c > 0) {
#pragma unroll
            for (int R = 0; R < NR; ++R)
#pragma unroll
                for (int i = 0; i < 4; ++i) { const int n = 16 * R + 4 * fqo + i; const f32x2 rs = ((const LAS f32x2*)(L + RT_ROW))[n];
                    const size_t row = (size_t)(rowbase + C * (c - 1) + n); const int col = h * 128 + 16 * w + fro;
                    const float sg = bf2f(F.SG()[row * 512 + col]);
                    F.H()[row * DM + col] = (unsigned short)f2bf((o[R][i] - rs[0]) * rs[1] * sg); asm volatile("" ::: "memory"); }
        }
        if (c == nchunks) break;
        __builtin_amdgcn_sched_barrier(0);
        for (int tile = w; tile < NR * NR; tile += 8) { const int nt = tile / NR, mt = tile % NR;
            f32x4 a = (f32x4){0.f, 0.f, 0.f, 0.f};
            if (nt >= mt) {
#pragma unroll
                for (int s = 0; s < 4; ++s) { const bf16x8 qa = *(const LAS bf16x8*)(L + RT_Q + (16 * nt + fr) * 272 + (32 * s + 8 * fq) * 2), kb = *(const LAS bf16x8*)(L + RT_K + (16 * mt + fr) * 272 + (32 * s + 8 * fq) * 2);
                    a = __builtin_amdgcn_mfma_f32_16x16x32_bf16(qa, kb, a, 0, 0, 0); }
            }
#pragma unroll
            for (int i = 0; i < 4; ++i) { const int n = 16 * nt + 4 * fqo + i, m = 16 * mt + fro; const float v = (n >= m) ? a[i] * exp2f(lg2g * (float)(n - m)) : 0.f;
                *(LAS unsigned short*)(L + RT_SC + n * 144 + m * 2) = (unsigned short)f2bf(v); }
        }
        __syncthreads();
        f32x4 oin[NR], ocr[NR];
#pragma unroll
        for (int R = 0; R < NR; ++R) { oin[R] = (f32x4){0.f, 0.f, 0.f, 0.f}; ocr[R] = (f32x4){0.f, 0.f, 0.f, 0.f}; }
        __builtin_amdgcn_sched_barrier(0);
        bf16x8 bv[KS];
#pragma unroll
        for (int s = 0; s < KS; ++s) { bv[s] = *(const LAS bf16x8*)(L + RT_VT + (16 * w + fr) * 144 + (32 * s + 8 * fq) * 2);
#pragma unroll
            for (int R = 0; R < NR; ++R) { const bf16x8 a = *(const LAS bf16x8*)(L + RT_SC + (16 * R + fr) * 144 + (32 * s + 8 * fq) * 2); oin[R] = __builtin_amdgcn_mfma_f32_16x16x32_bf16(a, bv[s], oin[R], 0, 0, 0); } }
        __builtin_amdgcn_sched_barrier(0);
#pragma unroll
        for (int s = 0; s < 4; ++s) { const bf16x8 bs = *(const LAS bf16x8*)(L + RT_ST + (16 * w + fr) * 272 + (32 * s + 8 * fq) * 2);
#pragma unroll
            for (int R = 0; R < NR; ++R) { const bf16x8 a = *(const LAS bf16x8*)(L + RT_Q + (16 * R + fr) * 272 + (32 * s + 8 * fq) * 2); ocr[R] = __builtin_amdgcn_mfma_f32_16x16x32_bf16(a, bs, ocr[R], 0, 0, 0); } }
        __builtin_amdgcn_sched_barrier(0);
#pragma unroll
        for (int R = 0; R < NR; ++R)
#pragma unroll
            for (int i = 0; i < 4; ++i) o[R][i] = oin[R][i] + ocr[R][i] * exp2f(lg2g * (float)(16 * R + 4 * fqo + i + 1));
        __builtin_amdgcn_sched_barrier(0);
#pragma unroll
        for (int T = 0; T < 8; ++T) S[T] = S[T] * gC;
#pragma unroll
        for (int s = 0; s < KS; ++s)
#pragma unroll
            for (int T = 0; T < 8; ++T) { const bf16x8 a = *(const LAS bf16x8*)(L + RT_KT + (16 * T + fr) * 144 + (32 * s + 8 * fq) * 2); S[T] = __builtin_amdgcn_mfma_f32_16x16x32_bf16(a, bv[s], S[T], 0, 0, 0); }
#pragma unroll
        for (int T = 0; T < 8; ++T) *(LAS v2u*)(L + RT_ST + (16 * w + fr) * 272 + (16 * T + 4 * fq) * 2) = (v2u){pk2(S[T][0], S[T][1]), pk2(S[T][2], S[T][3])};
        __builtin_amdgcn_sched_barrier(0);
#pragma unroll
        for (int R = 0; R < NR; ++R)
#pragma unroll
            for (int i = 0; i < 4; ++i) { float s = o[R][i];
                s += __shfl_xor(s, 1); s += __shfl_xor(s, 2); s += __shfl_xor(s, 4); s += __shfl_xor(s, 8);
                const float mw = s * (1.f / 16.f); const float d = o[R][i] - mw; float q = d * d;
                q += __shfl_xor(q, 1); q += __shfl_xor(q, 2); q += __shfl_xor(q, 4); q += __shfl_xor(q, 8);
                if (fr == 0) ((LAS f32x2*)(L + RT_STATS))[(16 * R + 4 * fq + i) * 8 + w] = (f32x2){mw, q}; }
        __syncthreads();
    }
    __syncthreads();
#pragma unroll
    for (int T = 0; T < 8; ++T)
#pragma unroll
        for (int i = 0; i < 4; ++i) *(LAS float*)(L + ((16 * T + 4 * fq + i) * 128 + 16 * w + fr) * 4) = S[T][i];
    __syncthreads();
#pragma unroll 2
    for (int i = 0; i < 8; ++i) *(GAS f32x4*)(Sout + (size_t)(tid + 512 * i) * 4) = *(const LAS f32x4*)(L + (tid + 512 * i) * 16);
    __syncthreads();
#undef RET_ISSUE
}

constexpr int SCP = 2116;
__device__ __forceinline__ unsigned sortable(float v) { const unsigned u = __builtin_bit_cast(unsigned, v + 0.f); return (u & 0x80000000u) ? ~u : (u | 0x80000000u); }
template <bool SAMPLE> __device__ __forceinline__ void idx_unit(Frame& F, int b, int g) {
    const int lane = F.lane, w = F.wave, fr = lane & 15, fq = lane >> 4;
    const int q0 = SAMPLE ? MP + b * 32 + 16 * g : b * 2048 + 16 * g;
    const int L = SAMPLE ? 2080 : 64 * ((g >> 2) + 1);
    LAS float* SC = (LAS float*)F.lds;
    bf16x8 bq[8][2]; float iw[8];
#pragma unroll
    for (int h = 0; h < 8; ++h) {
#pragma unroll
        for (int s = 0; s < 2; ++s) bq[h][s] = *(const GAS bf16x8*)(F.IQ() + (size_t)(q0 + fr) * 512 + h * 64 + 32 * s + 8 * fq);
        iw[h] = F.IWF()[(size_t)(q0 + fr) * 8 + h];
    }
    __syncthreads();
    for (int t = w; t < L / 16; t += 8) {
        bf16x8 a[2];
        if (SAMPLE && t < 128) {
            const float* kp = F.cache_ik() + ((size_t)b * 2048 + 16 * t + fr) * 64 + 8 * fq;
#pragma unroll
            for (int s = 0; s < 2; ++s) { const f32x4 x0 = *(const GAS f32x4*)(kp + 32 * s), x1 = *(const GAS f32x4*)(kp + 32 * s + 4);
                const v4u pw = (v4u){pk2(x0[0], x0[1]), pk2(x0[2], x0[3]), pk2(x1[0], x1[1]), pk2(x1[2], x1[3])}; a[s] = __builtin_bit_cast(bf16x8, pw); }
        } else {
            const size_t krow = SAMPLE ? (size_t)(MP + b * 32 + (16 * t - 2048) + fr) : (size_t)(b * 2048 + 16 * t + fr);
#pragma unroll
            for (int s = 0; s < 2; ++s) a[s] = *(const GAS bf16x8*)(F.IKB() + krow * 64 + 32 * s + 8 * fq);
        }
        f32x4 sc = (f32x4){0.f, 0.f, 0.f, 0.f};
#pragma unroll
        for (int h = 0; h < 8; ++h) { f32x4 acc = (f32x4){0.f, 0.f, 0.f, 0.f};
            acc = __builtin_amdgcn_mfma_f32_16x16x32_bf16(a[0], bq[h][0], acc, 0, 0, 0); acc = __builtin_amdgcn_mfma_f32_16x16x32_bf16(a[1], bq[h][1], acc, 0, 0, 0);
#pragma unroll
            for (int i = 0; i < 4; ++i) sc[i] += iw[h] * __builtin_fmaxf(acc[i], 0.f); }
        *(LAS f32x4*)(SC + fr * SCP + 16 * t + 4 * fq) = sc;
    }
    __syncthreads();
    const int NI = (L + 63) >> 6;
    const unsigned long long lt = (1ull << lane) - 1ull;
    for (int qi = 0; qi < 2; ++qi) {
        const int qq = 2 * w + qi; const LAS float* sr = SC + qq * SCP;
        int ln = lane; asm volatile("" : "+v"(ln));
        unsigned u[33];
#pragma unroll
        for (int i = 0; i < 33; ++i) { const int key = 64 * i + ln; u[i] = (key < L) ? sortable(sr[key]) : 0u; }
        unsigned prefix = 0u;
        for (int bit = 31; bit >= 0; --bit) { const unsigned cand = prefix | (1u << bit); int c = 0;
#pragma unroll
            for (int i = 0; i < 33; ++i) c += (u[i] >= cand) ? 1 : 0;
            c = wave_sum_i(c);
            if (c >= 256) prefix = cand; }
        int cg = 0;
#pragma unroll
        for (int i = 0; i < 33; ++i) cg += (u[i] > prefix) ? 1 : 0;
        const int need = 256 - wave_sum_i(cg);
        int running = 0; unsigned long long mw = 0ull;
#pragma unroll
        for (int i = 0; i < 33; ++i) { if (i < NI) { const bool gt = u[i] > prefix, eq = u[i] == prefix;
                const unsigned long long beq = __ballot(eq); const int rank = running + __popcll(beq & lt);
                const unsigned long long bsel = __ballot(gt || (eq && rank < need)); running += __popcll(beq);
                if (ln == i) mw = bsel; } __builtin_amdgcn_sched_barrier(0); }
        if (lane < NI) F.MASK()[(size_t)(q0 + qq) * MASKP + lane] = mw;
    }
}

__device__ __forceinline__ float fexp2(float x) { return __builtin_amdgcn_exp2f(x); }
__device__ __forceinline__ void att_tile(const LAS unsigned char* Kt, const LAS unsigned char* Vt, const bf16x8 (&qf)[4], unsigned long long mw, int r32, int hi, float& m_run, float& l_run, f32x16 (&ot)[2]) {
    f32x16 p0, p1;
#pragma unroll
    for (int r = 0; r < 16; ++r) { p0[r] = 0.f; p1[r] = 0.f; }
#pragma unroll
    for (int s = 0; s < 4; ++s) { const bf16x8 k0 = *(const LAS bf16x8*)(Kt + r32 * 144 + (16 * s + 8 * hi) * 2), k1 = *(const LAS bf16x8*)(Kt + (32 + r32) * 144 + (16 * s + 8 * hi) * 2);
        p0 = __builtin_amdgcn_mfma_f32_32x32x16_bf16(k0, qf[s], p0, 0, 0, 0); p1 = __builtin_amdgcn_mfma_f32_32x32x16_bf16(k1, qf[s], p1, 0, 0, 0); }
    const unsigned mlo = (unsigned)(mw >> (4 * hi)), mhi = (unsigned)(mw >> (32 + 4 * hi));
    float mx = -1e30f;
#pragma unroll
    for (int r = 0; r < 16; ++r) { const int bit = (r & 3) + 8 * (r >> 2);
        if ((mlo >> bit) & 1u) mx = __builtin_fmaxf(mx, p0[r]); if ((mhi >> bit) & 1u) mx = __builtin_fmaxf(mx, p1[r]); }
    mx = __builtin_fmaxf(mx, __shfl_xor(mx, 32));
    const float mn = __builtin_fmaxf(m_run, mx), alpha = fexp2(m_run - mn); m_run = mn;
    float ls = 0.f;
#pragma unroll
    for (int r = 0; r < 16; ++r) { const int bit = (r & 3) + 8 * (r >> 2);
        p0[r] = ((mlo >> bit) & 1u) ? fexp2(p0[r] - mn) : 0.f; p1[r] = ((mhi >> bit) & 1u) ? fexp2(p1[r] - mn) : 0.f; ls += p0[r] + p1[r]; }
    l_run = l_run * alpha + ls;
#pragma unroll
    for (int r = 0; r < 16; ++r) { ot[0][r] *= alpha; ot[1][r] *= alpha; }
    bf16x8 pa[2][2];
#pragma unroll
    for (int s2 = 0; s2 < 2; ++s2) {
        const v4u w0 = (v4u){pk2(p0[8 * s2], p0[8 * s2 + 1]), pk2(p0[8 * s2 + 2], p0[8 * s2 + 3]), pk2(p0[8 * s2 + 4], p0[8 * s2 + 5]), pk2(p0[8 * s2 + 6], p0[8 * s2 + 7])};
        const v4u w1 = (v4u){pk2(p1[8 * s2], p1[8 * s2 + 1]), pk2(p1[8 * s2 + 2], p1[8 * s2 + 3]), pk2(p1[8 * s2 + 4], p1[8 * s2 + 5]), pk2(p1[8 * s2 + 6], p1[8 * s2 + 7])};
        pa[0][s2] = __builtin_bit_cast(bf16x8, w0); pa[1][s2] = __builtin_bit_cast(bf16x8, w1); }
#pragma unroll
    for (int db = 0; db < 2; ++db)
#pragma unroll
        for (int kb = 0; kb < 2; ++kb)
#pragma unroll
            for (int s2 = 0; s2 < 2; ++s2) { const LAS unsigned char* vp = Vt + (32 * db + r32) * 136 + (32 * kb + 16 * s2 + 4 * hi) * 2;
                const v2u lo = *(const LAS v2u*)vp, hi4 = *(const LAS v2u*)(vp + 16); const v4u vv = (v4u){lo[0], lo[1], hi4[0], hi4[1]};
                ot[db] = __builtin_amdgcn_mfma_f32_32x32x16_bf16(__builtin_bit_cast(bf16x8, vv), pa[kb][s2], ot[db], 0, 0, 0); }
}
constexpr int AT_K = 0, AT_VT = 9216, AT_END = 9216 + 8704;
__device__ __forceinline__ void att_unit_prompt(Frame& F, int b, int h, int u8) {
    const int tid = F.tid, lane = F.lane, w = F.wave, r32 = lane & 31, hi = lane >> 5;
    LAS unsigned char* L = F.lds;
    const size_t rowb = (size_t)b * 2048; const int q0w = 256 * u8 + 32 * w, qc = q0w >> 6, ntw = qc + 1, NT = 4 * u8 + 4;
    bf16x8 qf[4];
#pragma unroll
    for (int s = 0; s < 4; ++s) qf[s] = *(const GAS bf16x8*)(F.AQ() + (rowb + q0w + r32) * 512 + h * 64 + 16 * s + 8 * hi);
    float m_run = -1e30f, l_run = 0.f; f32x16 ot[2];
#pragma unroll
    for (int r = 0; r < 16; ++r) { ot[0][r] = 0.f; ot[1][r] = 0.f; }
    const int key = tid >> 3, dch = tid & 7;
    for (int t = 0; t < NT; ++t) {
        const size_t goff = (rowb + 64 * t + key) * 512 + h * 64 + 8 * dch;
        const v4u kv = *(const GAS v4u*)(F.AK() + goff), vv = *(const GAS v4u*)(F.AV() + goff);
        unsigned long long mw = ~0ull;
        if (qc >= 4 && t < ntw) mw = F.MASK()[(rowb + q0w + r32) * MASKP + t];
        __syncthreads();
        *(LAS v4u*)(L + AT_K + key * 144 + dch * 16) = kv;
#pragma unroll
        for (int jj = 0; jj < 4; ++jj) { *(LAS unsigned short*)(L + AT_VT + (8 * dch + 2 * jj) * 136 + key * 2) = (unsigned short)(vv[jj] & 0xffffu);
            *(LAS unsigned short*)(L + AT_VT + (8 * dch + 2 * jj + 1) * 136 + key * 2) = (unsigned short)(vv[jj] >> 16); }
        __syncthreads();
        if (t < ntw) att_tile(L + AT_K, L + AT_VT, qf, mw, r32, hi, m_run, l_run, ot);
    }
    const float lt = l_run + __shfl_xor(l_run, 32), inv = 1.f / lt;
    bf16* op = F.H() + (rowb + q0w + r32) * DM + 512 + h * 64;
#pragma unroll
    for (int db = 0; db < 2; ++db)
#pragma unroll
        for (int rg = 0; rg < 4; ++rg) { const int d = 32 * db + 8 * rg + 4 * hi;
            *(GAS v2u*)(op + d) = (v2u){pk2(ot[db][4 * rg] * inv, ot[db][4 * rg + 1] * inv), pk2(ot[db][4 * rg + 2] * inv, ot[db][4 * rg + 3] * inv)}; }
    __syncthreads();
}
constexpr int SA_WB = 17920;
__device__ __forceinline__ void att_unit_sample(Frame& F, int b, int h) {
    const int tid = F.tid, lane = F.lane, w = F.wave, r32 = lane & 31, hi = lane >> 5;
    LAS unsigned char* Lw = F.lds + w * SA_WB;
    const size_t qrow = (size_t)MP + b * 32 + r32;
    bf16x8 qf[4];
#pragma unroll
    for (int s = 0; s < 4; ++s) qf[s] = *(const GAS bf16x8*)(F.AQ() + qrow * 512 + h * 64 + 16 * s + 8 * hi);
    float m_run = -1e30f, l_run = 0.f; f32x16 ot[2];
#pragma unroll
    for (int r = 0; r < 16; ++r) { ot[0][r] = 0.f; ot[1][r] = 0.f; }
    for (int t = w; t < 33; t += 8) {
        const unsigned long long mw = F.MASK()[qrow * MASKP + t];
        if (t < 32) {
#pragma unroll 4
            for (int i = 0; i < 16; ++i) { const int key = 4 * i + (lane >> 4), d4 = (lane & 15) * 4; const size_t go = (((size_t)b * 2048 + 64 * t + key) * 8 + h) * 64 + d4;
                const f32x4 kx = *(const GAS f32x4*)(F.cache_k() + go), vx = *(const GAS f32x4*)(F.cache_v() + go);
                *(LAS v2u*)(Lw + key * 144 + d4 * 2) = (v2u){pk2(kx[0], kx[1]), pk2(kx[2], kx[3])};
#pragma unroll
                for (int jj = 0; jj < 4; ++jj) *(LAS unsigned short*)(Lw + 9216 + (d4 + jj) * 136 + key * 2) = (unsigned short)f2bf(vx[jj]); }
        } else {
            for (int i = 0; i < 18; ++i) { const int o = (i * 64 + lane) * 16; if (o < SA_WB) *(LAS v4u*)(Lw + o) = (v4u){0u, 0u, 0u, 0u}; }
            LDS_WAIT(); asm volatile("" ::: "memory");
#pragma unroll
            for (int i = 0; i < 4; ++i) { const int key = 8 * i + (lane >> 3), d8 = (lane & 7) * 8; const size_t go = ((size_t)MP + b * 32 + key) * 512 + h * 64 + d8;
                const v4u kv = *(const GAS v4u*)(F.AK() + go), vv = *(const GAS v4u*)(F.AV() + go);
                *(LAS v4u*)(Lw + key * 144 + d8 * 2) = kv;
#pragma unroll
                for (int jj = 0; jj < 4; ++jj) { *(LAS unsigned short*)(Lw + 9216 + (d8 + 2 * jj) * 136 + key * 2) = (unsigned short)(vv[jj] & 0xffffu);
                    *(LAS unsigned short*)(Lw + 9216 + (d8 + 2 * jj + 1) * 136 + key * 2) = (unsigned short)(vv[jj] >> 16); } }
        }
        LDS_WAIT(); asm volatile("" ::: "memory");
        att_tile(Lw, Lw + 9216, qf, mw, r32, hi, m_run, l_run, ot);
        LDS_WAIT(); asm volatile("" ::: "memory");
    }
    __syncthreads();
    LAS float* Mx = (LAS float*)F.lds; LAS float* Lc = Mx + 256; LAS float* Oc = Mx + 512;
    if (hi == 0) Mx[w * 32 + r32] = m_run;
    __syncthreads();
    float ms = Mx[r32];
#pragma unroll
    for (int k = 1; k < 8; ++k) ms = __builtin_fmaxf(ms, Mx[k * 32 + r32]);
    const float scl = fexp2(m_run - ms); const float lt = (l_run + __shfl_xor(l_run, 32)) * scl;
    if (hi == 0) Lc[w * 32 + r32] = lt;
#pragma unroll
    for (int db = 0; db < 2; ++db)
#pragma unroll
        for (int rg = 0; rg < 4; ++rg) { const int d = 32 * db + 8 * rg + 4 * hi;
            *(LAS f32x4*)(Oc + (w * 32 + r32) * 64 + d) = (f32x4){ot[db][4 * rg] * scl, ot[db][4 * rg + 1] * scl, ot[db][4 * rg + 2] * scl, ot[db][4 * rg + 3] * scl}; }
    __syncthreads();
    { const int q = tid >> 4, d4 = (tid & 15) * 4; f32x4 s = (f32x4){0.f, 0.f, 0.f, 0.f}; float l = 0.f;
#pragma unroll
        for (int k = 0; k < 8; ++k) { s += *(const LAS f32x4*)(Oc + (k * 32 + q) * 64 + d4); l += Lc[k * 32 + q]; }
        const float inv = 1.f / l;
        *(GAS v2u*)(F.H() + ((size_t)MP + b * 32 + q) * DM + 512 + h * 64 + d4) = (v2u){pk2(s[0] * inv, s[1] * inv), pk2(s[2] * inv, s[3] * inv)}; }
    __syncthreads();
}

__global__ void __launch_bounds__(NWAVES * 64, 2) mk_fwd(Args args) {
    extern __shared__ __attribute__((aligned(16))) unsigned char lds[];
    Frame F;
    F.lds = (LAS unsigned char*)lds;
    F.MISC = (volatile LAS unsigned*)(F.lds + MISC_OFF);
    F.tid = threadIdx.x; F.lane = F.tid & 63; F.wave = __builtin_amdgcn_readfirstlane(F.tid >> 6);
    F.G = gridDim.x; { const int bx = blockIdx.x; F.vcu = (F.G % 8 == 0) ? (bx % 8) * (F.G / 8) + bx / 8 : bx; }
    F.a = &args; F.ws = args.ws;
    if (F.tid < 32) F.MISC[F.tid] = 0u;
    __syncthreads();
    XcdBarrier bar; bar.bar = (unsigned*)(F.ctl() + CW_BAR); bar.x = 0; bar.st = nullptr;
    if (N_LAUNCHES == 1) bar = xcd_barrier_post((unsigned*)(F.ctl() + CW_BAR), F.MISC + 8);
#define GRID_BAR() do { if (N_LAUNCHES == 1) xcd_barrier(bar); } while (0)
    const int lo = args.ph_lo, hi = args.ph_hi;
#ifndef P6SEL
#define P6SEL 15
#endif
#ifndef PHMASK
#define PHMASK 0x1fff
#endif
#define IN(k) (((PHMASK >> (k)) & 1) && lo <= (k) && (k) < hi)
#define BOTH(k) (IN(k) && IN((k) + 1))
    if (IN(0)) { p0_prologue(F); if (BOTH(0)) GRID_BAR(); }
    if (IN(1)) { p1_modulate(F); if (BOTH(1)) GRID_BAR(); }
    if (IN(2)) { pg8::Gemm g{F.H(), F.WGU1(), MROWS, NGU, DM}; pg8::StaticOrder S; S.init(MROWS, NGU, F.G, (int)blockIdx.x); pg8::EpiSwiGLU E{F.ACT()};
        pg8::gemm_phase<pg8::EpiSwiGLU, pg8::StaticOrder, true, true>(F.lds, g, S, E); if (BOTH(2)) GRID_BAR(); }
    if (IN(3)) { pg8::Gemm g{F.ACT(), F.WD1(), MROWS, DM, FF}; pg8::StaticOrder S; S.init(MROWS, DM, F.G, (int)blockIdx.x); pg8::EpiResid E{F.xp(), F.xs(), F.XT(), F.MOD(), 2 * DM, 0.5f};
        pg8::gemm_phase<pg8::EpiResid, pg8::StaticOrder, true, true>(F.lds, g, S, E); if (BOTH(3)) GRID_BAR(); }
    if (IN(4)) { ln_pass(F, F.XT(), F.XT(), F.H(), F.ln1g(), F.ln1b(), 3 * DM); if (BOTH(4)) GRID_BAR(); }
    if (IN(5)) { pg8::Gemm g{F.H(), F.WIN(), MROWS, NIN, DM}; pg8::StaticOrder S; S.init(MROWS, NIN, F.G, (int)blockIdx.x);
        pg8::EpiMix E{F.RQ(), F.RK(), F.RV(), F.SG(), F.AQ(), F.AK(), F.AV(), F.IQ(), F.IKB(), F.IWF(), F.out(), F.RT1(), F.RT2()};
        pg8::gemm_phase<pg8::EpiMix, pg8::StaticOrder, true, true>(F.lds, g, S, E); if (BOTH(5)) GRID_BAR(); }
    if (IN(6)) {
        for (;;) { const int t = next_ticket(F, 0); if (t >= 672) break;
            if (t < 32) { if (P6SEL & 1) { const int b = t >> 2, h = t & 3; ret_unit<64>(F, b * 2048, 32, h, nullptr, F.out() + O_SRP + (size_t)t * 16384); } }
            else if (t < 480) { if (P6SEL & 2) { const int p = t - 32, b = p / 56, k = p % 56; idx_unit<false>(F, b, 16 + k); idx_unit<false>(F, b, 127 - k); } }
            else if (t < 544) { if (P6SEL & 4) { const int p = t - 480; idx_unit<true>(F, p >> 1, p & 1); } }
            else { if (P6SEL & 8) { const int p = t - 544, b = p >> 2, h = p & 3; ret_unit<32>(F, MP + b * 32, 1, h, F.state_ret() + (size_t)p * 16384, F.out() + O_SRS + (size_t)p * 16384); } }
        }
        if (BOTH(6)) GRID_BAR();
    }
    if (IN(7)) {
        for (;;) { const int t = next_ticket(F, 1); if (t >= 512) break;
            if (t < 256) { const int b = t >> 5, h = (t >> 2) & 7, k = t & 3; att_unit_prompt(F, b, h, 7 - k); att_unit_prompt(F, b, h, k); }
            else { const int p = t - 256; att_unit_sample(F, p >> 3, p & 7); }
        }
        if (BOTH(7)) GRID_BAR();
    }
    if (IN(8)) { pg8::Gemm g{F.H(), F.WOUT(), MROWS, DM, DM}; pg8::StaticOrder S; S.init(MROWS, DM, F.G, (int)blockIdx.x); pg8::EpiResid E{F.XT(), F.XT() + (size_t)MP * DM, F.XT(), F.MOD(), 5 * DM, 1.0f};
        pg8::gemm_phase<pg8::EpiResid, pg8::StaticOrder, true, true>(F.lds, g, S, E); if (BOTH(8)) GRID_BAR(); }
    if (IN(9)) { ln_pass(F, F.XT(), F.XT(), F.H(), F.ln2g(), F.ln2b(), 6 * DM); if (BOTH(9)) GRID_BAR(); }
    if (IN(10)) { pg8::Gemm g{F.H(), F.WGU2(), MROWS, NGU, DM}; pg8::StaticOrder S; S.init(MROWS, NGU, F.G, (int)blockIdx.x); pg8::EpiSwiGLU E{F.ACT()};
        pg8::gemm_phase<pg8::EpiSwiGLU, pg8::StaticOrder, true, true>(F.lds, g, S, E); if (BOTH(10)) GRID_BAR(); }
    if (IN(11)) { pg8::Gemm g{F.ACT(), F.WD2(), MROWS, DM, FF}; pg8::StaticOrder S; S.init(MROWS, DM, F.G, (int)blockIdx.x); pg8::EpiResid E{F.XT(), F.XT() + (size_t)MP * DM, F.XT(), F.MOD(), 8 * DM, 0.5f};
        pg8::gemm_phase<pg8::EpiResid, pg8::StaticOrder, true, true>(F.lds, g, S, E); if (BOTH(11)) GRID_BAR(); }
    if (IN(12)) { ln_pass(F, F.XT(), F.out(), nullptr, F.ln3g(), F.ln3b(), 0); }
#undef IN
#undef BOTH
#undef GRID_BAR
}

extern "C" void kernel_launch(void* const* d_in, const int* in_sizes, int n_in, void* d_out, int out_size, void* d_ws, size_t ws_size, hipStream_t stream) {
    static int grid = 0;
    if (grid == 0) {
        if (n_in != 24 || out_size != (int)O_END || ws_size < WS_END) { fprintf(stderr, "kernel_launch: unexpected sizes n_in %d out %d ws %zu\n", n_in, out_size, ws_size); grid = -1; return; }
        int dev = 0, cus = 0;
        if (hipGetDevice(&dev) != hipSuccess || hipDeviceGetAttribute(&cus, hipDeviceAttributeMultiprocessorCount, dev) != hipSuccess) { grid = -1; return; }
        if (hipFuncSetAttribute((const void*)mk_fwd, hipFuncAttributeMaxDynamicSharedMemorySize, LDS_BYTES) != hipSuccess) { fprintf(stderr, "kernel_launch: hipFuncSetAttribute failed\n"); grid = -1; return; }
        int per_cu = 0;
        if (hipOccupancyMaxActiveBlocksPerMultiprocessor(&per_cu, (const void*)mk_fwd, NWAVES * 64, LDS_BYTES) != hipSuccess || per_cu < 1) fprintf(stderr, "kernel_launch: occupancy query says %d\n", per_cu);
        (void)hipGetLastError();
        grid = cus;
    }
    if (grid < 0) return;
    (void)hipMemsetAsync((char*)d_ws + WS_CTL, 0, CTL_ZERO_BYTES, stream);
    Args a{};
    for (int i = 0; i < 24; ++i) a.in[i] = (const float*)d_in[i];
    a.out = (float*)d_out; a.ws = (unsigned char*)d_ws;
    if (N_LAUNCHES == 1) { a.ph_lo = 0; a.ph_hi = NPHASE; a.li = 0; hipLaunchKernelGGL(mk_fwd, dim3(grid), dim3(NWAVES * 64), LDS_BYTES, stream, a); }
    else for (int li = 0; li < NPHASE; ++li) { a.ph_lo = li; a.ph_hi = li + 1; a.li = li; hipLaunchKernelGGL(mk_fwd, dim3(grid), dim3(NWAVES * 64), LDS_BYTES, stream, a); }
}
```

```cpp
#include <hip/hip_runtime.h>
#include <cstdio>
#include <cstdint>

constexpr int MP = 16384, MS = 1024, MROWS = MP + MS;
constexpr int DM = 1024, FF = 2816, NGU = 2 * FF, NIN = 4352, DIN = 4168, NMOD = 9 * DM;
constexpr float LN_EPS = 1e-5f;
constexpr float ALPHA = 1.189207115002721f;
constexpr float C2Q = 0.125f * 1.4426950408889634f;
constexpr float RK_SCALE = 0.08838834764831845f;
constexpr float IW_SCALE = 0.35355339059327373f * 0.125f;
constexpr size_t O_YP = 0, O_YS = 16777216, O_NKP = 17825792, O_NVP = 26214400, O_NIP = 34603008, O_SRP = 35651584,
                 O_NKS = 36175872, O_NVS = 36700160, O_NIS = 37224448, O_SRS = 37289984, O_END = 39387136;
#define MK_N_LAUNCHES 1
namespace pg8 {
#define PG8_LAS __attribute__((address_space(3)))
typedef unsigned short bf16_t;
typedef short bf16x8 __attribute__((ext_vector_type(8)));
typedef float f32x4 __attribute__((ext_vector_type(4)));
typedef unsigned u32x4 __attribute__((ext_vector_type(4)));
constexpr int BM = 256, BK = 64, HALF = 128, HTB = HALF * BK * 2  , STAGE_BYTES = 8 * HTB, NXCD = 8, WGM = 8;

__host__ __device__ __forceinline__ int lds_byte(int r, int c) { const int st = (r >> 4) * 2 + (c >> 5), rr = r & 15, cc = c & 31, ob = rr * 64 + cc * 2; return st * 1024 + (ob ^ (((ob >> 9) & 1) << 5)); }
__host__ __device__ __forceinline__ void stage_rc(int b, int& R, int& C) { const int st = b / 1024, sb = b % 1024, swz = sb ^ (((sb >> 9) & 1) << 5); R = (st >> 1) * 16 + swz / 64; C = (st & 1) * 32 + (swz % 64) / 2; }
__host__ __device__ __forceinline__ int perm32(int rho) { const int n = rho >> 4, i = rho & 15; return 8 * (i >> 2) + 4 * n + (i & 3); }

struct Unit { int pm, pn; };
struct Gemm { const bf16_t* A; const bf16_t* Bt; int M, N, K; };

struct StaticOrder {
    int nM, nN, nwg, G, c;
    __host__ __device__ void init(int M, int N, int G_, int c_) { nM = M / BM; nN = N / BM; nwg = nM * nN; G = G_; c = c_; }
    __host__ __device__ bool next(int i, Unit& u) const {
        const long L = (long)i * G + c; if (L >= nwg) return false;
        int wgid = (int)L; { const int q = nwg / NXCD, r = nwg % NXCD, xcd = wgid % NXCD, off = wgid / NXCD; wgid = (xcd < r ? xcd * (q + 1) : r * (q + 1) + (xcd - r) * q) + off; }
        const int nig = WGM * nN, gid = wgid / nig, fm = gid * WGM, gsz = (nM - fm) < WGM ? (nM - fm) : WGM;
        u.pm = fm + ((wgid % nig) % gsz); u.pn = (wgid % nig) / gsz; return true;
    }
    __device__ __forceinline__ void a_ready(const Unit&) const {}
    __device__ __forceinline__ void done(const Unit&) const {}
};

__device__ __forceinline__ unsigned cvt_pk_bf16(float lo, float hi) { unsigned r; asm volatile("v_cvt_pk_bf16_f32 %0, %1, %2" : "=v"(r) : "v"(lo), "v"(hi)); return r; }
typedef float f32x2 __attribute__((ext_vector_type(2)));
typedef unsigned u32x2 __attribute__((ext_vector_type(2)));
__device__ __forceinline__ float silu_f(float g) { return g * __builtin_amdgcn_rcpf(1.f + __builtin_amdgcn_exp2f(-1.4426950408889634f * g)); }
__device__ __forceinline__ int batch_of_row(int r) { return r < MP ? (r >> 11) : 8 + ((r - MP) >> 5); }
__device__ __forceinline__ int pos_of_row(int r) { return r < MP ? (r & 2047) : 2048 + (r & 31); }
__device__ __forceinline__ u32x4 pack8(const f32x4 a, const f32x4 b) { u32x4 w; w.x = cvt_pk_bf16(a[0], a[1]); w.y = cvt_pk_bf16(a[2], a[3]); w.z = cvt_pk_bf16(b[0], b[1]); w.w = cvt_pk_bf16(b[2], b[3]); return w; }

struct EpiSwiGLU {
    static constexpr bool PERM = true, AFTER_DRAIN = false;
    bf16_t* O;
    __device__ __forceinline__ void operator()(const f32x4 (&acc)[2][2][4][2], const Unit& u, int wr, int wc, int fr, int fq) const {
        const int row0 = u.pm * BM + wr * 64 + fr, col0 = u.pn * 128 + wc * 32 + 8 * fq;
#pragma unroll
        for (int ai = 0; ai < 2; ++ai)
#pragma unroll
            for (int m = 0; m < 4; ++m) {
                bf16_t* rowp = O + (size_t)(row0 + ai * HALF + m * 16) * FF + col0;
                f32x4 v0, v1;
#pragma unroll
                for (int e = 0; e < 4; ++e) { v0[e] = silu_f(acc[ai][0][m][0][e]) * acc[ai][1][m][0][e]; v1[e] = silu_f(acc[ai][0][m][1][e]) * acc[ai][1][m][1][e]; }
                *(u32x4*)rowp = pack8(v0, v1);
            }
    }
};

struct EpiResid {
    static constexpr bool PERM = false, AFTER_DRAIN = false;
    const float* Xp; const float* Xs; float* T; const float* mod; int gate_off; float w;
    __device__ __forceinline__ void operator()(const f32x4 (&acc)[2][2][4][2], const Unit& u, int wr, int wc, int fr, int fq) const {
        const int row0 = u.pm * BM + wr * 64 + fr, col0 = u.pn * BM + wc * 32 + 4 * fq;
#pragma unroll
        for (int ai = 0; ai < 2; ++ai)
#pragma unroll
            for (int m = 0; m < 4; ++m) {
                const int r = row0 + ai * HALF + m * 16;
                const float* gp = mod + (size_t)batch_of_row(r) * NMOD + gate_off + col0;
                const float* xp = (r < MP ? Xp + (size_t)r * DM : Xs + (size_t)(r - MP) * DM) + col0;
                float* tp = T + (size_t)r * DM + col0;
#pragma unroll
                for (int bj = 0; bj < 2; ++bj)
#pragma unroll
                    for (int n = 0; n < 2; ++n) {
                        const int c = bj * HALF + n * 16;
                        const f32x4 g = *(const f32x4*)(gp + c), x = *(const f32x4*)(xp + c);
                        *(f32x4*)(tp + c) = x * ALPHA + (g * w + w) * acc[ai][bj][m][n];
                    }
            }
    }
};

struct EpiMix {
    static constexpr bool PERM = true, AFTER_DRAIN = false;
    bf16_t *RQ, *RK, *RV, *SG, *AQ, *AK, *AV, *IQ, *IKB; float* IWF; float* out; const f32x2* RT1; const f32x2* RT2;
    __device__ __forceinline__ void operator()(const f32x4 (&acc)[2][2][4][2], const Unit& u, int wr, int wc, int fr, int fq) const {
        const int t = u.pn;
        const int row0 = u.pm * BM + wr * 64 + fr;
        if (t < 4) {
            const int head8 = 2 * t + (wc >> 1), j0 = 32 * (wc & 1) + 8 * fq;
            bf16_t* dst = (head8 < 4 ? RQ : RK) + (head8 & 3) * 128 + j0;
            const float sc = head8 < 4 ? 1.f : RK_SCALE;
#pragma unroll
            for (int ai = 0; ai < 2; ++ai)
#pragma unroll
                for (int m = 0; m < 4; ++m) {
                    const int r = row0 + ai * HALF + m * 16, pos = pos_of_row(r);
                    const f32x2* rt = RT1 + (size_t)pos * 64 + j0;
                    f32x4 o1[2], o2[2];
#pragma unroll
                    for (int n = 0; n < 2; ++n) {
                        const f32x4 cs01 = *(const f32x4*)(rt + 4 * n), cs23 = *(const f32x4*)(rt + 4 * n + 2);
                        const float cc[4] = {cs01[0], cs01[2], cs23[0], cs23[2]}, ss[4] = {cs01[1], cs01[3], cs23[1], cs23[3]};
#pragma unroll
                        for (int e = 0; e < 4; ++e) { const float x1 = acc[ai][0][m][n][e], x2 = acc[ai][1][m][n][e];
                            o1[n][e] = (x1 * cc[e] - x2 * ss[e]) * sc; o2[n][e] = (x2 * cc[e] + x1 * ss[e]) * sc; }
                    }
                    bf16_t* p = dst + (size_t)r * 512;
                    *(u32x4*)p = pack8(o1[0], o1[1]); *(u32x4*)(p + 64) = pack8(o2[0], o2[1]);
                }
        } else if (t < 8 || t == 12 || t == 13) {
            bf16_t* dst = (t < 6 ? RV + 256 * (t - 4) : t < 8 ? SG + 256 * (t - 6) : AV + 256 * (t - 12)) + wc * 32 + 8 * fq;
            float* fo = nullptr;
            if (t >= 12) fo = out + (u.pm < 64 ? O_NVP : O_NVS - (size_t)MP * 512) + 256 * (t - 12) + wc * 32 + 8 * fq;
#pragma unroll
            for (int ai = 0; ai < 2; ++ai)
#pragma unroll
                for (int m = 0; m < 4; ++m) {
                    const int r = row0 + ai * HALF + m * 16;
#pragma unroll
                    for (int bj = 0; bj < 2; ++bj) {
                        f32x4 v0 = acc[ai][bj][m][0], v1 = acc[ai][bj][m][1];
                        if (t == 6 || t == 7) {
#pragma unroll
                            for (int e = 0; e < 4; ++e) { v0[e] = silu_f(v0[e]); v1[e] = silu_f(v1[e]); }
                        }
                        *(u32x4*)(dst + (size_t)r * 512 + bj * HALF) = pack8(v0, v1);
                        if (fo) { *(f32x4*)(fo + (size_t)r * 512 + bj * HALF) = v0; *(f32x4*)(fo + (size_t)r * 512 + bj * HALF + 4) = v1; }
                    }
                }
        } else {
            const bool isik = (t == 16);
            if (isik && wc >= 2) return;
            if (isik && wc == 1) {
                if (fq == 0) {
#pragma unroll
                    for (int ai = 0; ai < 2; ++ai)
#pragma unroll
                        for (int m = 0; m < 4; ++m) { const int r = row0 + ai * HALF + m * 16;
                            *(f32x4*)(IWF + (size_t)r * 8) = acc[ai][0][m][0] * IW_SCALE; *(f32x4*)(IWF + (size_t)r * 8 + 4) = acc[ai][0][m][1] * IW_SCALE; }
                }
                return;
            }
            const int head = isik ? 0 : 4 * (t & 1) + wc;
            bf16_t* dst; int pitch; float sc = 1.f; float* fo = nullptr; int fpitch = 512;
            if (t < 10) { dst = AQ; pitch = 512; sc = C2Q; }
            else if (t < 12) { dst = AK; pitch = 512; fo = out + (u.pm < 64 ? O_NKP : O_NKS - (size_t)MP * 512); }
            else if (t < 16) { dst = IQ; pitch = 512; }
            else { dst = IKB; pitch = 64; fo = out + (u.pm < 64 ? O_NIP : O_NIS - (size_t)MP * 64); fpitch = 64; }
            const int d0 = (fq == 0) ? 0 : 16 + 8 * (fq - 1);
            const int d1 = (fq == 0) ? 8 : d0 + 24;
#pragma unroll
            for (int ai = 0; ai < 2; ++ai)
#pragma unroll
                for (int m = 0; m < 4; ++m) {
                    const int r = row0 + ai * HALF + m * 16;
                    f32x4 a0 = acc[ai][0][m][0], a1 = acc[ai][0][m][1], b0 = acc[ai][1][m][0], b1 = acc[ai][1][m][1];
                    if (fq == 0) {
                        const f32x2* rt = RT2 + (size_t)pos_of_row(r) * 8;
                        const f32x4 q0 = *(const f32x4*)(rt), q1 = *(const f32x4*)(rt + 2), q2 = *(const f32x4*)(rt + 4), q3 = *(const f32x4*)(rt + 6);
                        const float cc[8] = {q0[0], q0[2], q1[0], q1[2], q2[0], q2[2], q3[0], q3[2]}, ss[8] = {q0[1], q0[3], q1[1], q1[3], q2[1], q2[3], q3[1], q3[3]};
#pragma unroll
                        for (int e = 0; e < 4; ++e) {
                            const float x1 = a0[e], x2 = b0[e]; a0[e] = x1 * cc[e] - x2 * ss[e]; b0[e] = x2 * cc[e] + x1 * ss[e];
                            const float y1 = a1[e], y2 = b1[e]; a1[e] = y1 * cc[4 + e] - y2 * ss[4 + e]; b1[e] = y2 * cc[4 + e] + y1 * ss[4 + e];
                        }
                    }
                    if (fo) { float* f = fo + (size_t)r * fpitch + head * 64;
                        *(f32x4*)(f + d0) = a0; *(f32x4*)(f + d0 + 4) = a1; *(f32x4*)(f + d1) = b0; *(f32x4*)(f + d1 + 4) = b1; }
                    bf16_t* p = dst + (size_t)r * pitch + head * 64;
                    *(u32x4*)(p + d0) = pack8(a0 * sc, a1 * sc); *(u32x4*)(p + d1) = pack8(b0 * sc, b1 * sc);
                }
        }
    }
};

template <class Epi, class Sched, bool ALIGN_EPI = false, bool SP2 = false>
__device__ __forceinline__ void gemm_phase(PG8_LAS unsigned char* lds, const Gemm g, const Sched& S, const Epi& E) {
    const int tid = threadIdx.x, wid = __builtin_amdgcn_readfirstlane(tid >> 6), lane = tid & 63, wr = wid >> 2, wc = wid & 3, fr = lane & 15, fq = lane >> 4;
    const int K = g.K, nt = K / BK;
    unsigned voffA[2], voffB[2];
#pragma unroll
    for (int i = 0; i < 2; ++i) { int R, C; stage_rc(tid * 16 + i * 8192, R, C); const int Rb = Epi::PERM ? ((R & ~31) + perm32(R & 31)) : R;
        voffA[i] = (unsigned)(R * K + C) * 2u; voffB[i] = (unsigned)(Rb * K + C) * 2u; }
    const size_t kstep = (size_t)(BK * 2);
    const size_t hstep = (size_t)HALF * K * 2;
    const size_t tstep = 2 * hstep;
    const unsigned ldsw = (unsigned)wid * 1024u;
    const int aoff = lds_byte(wr * 64 + fr, fq * 8), boff = lds_byte(wc * 32 + fr, fq * 8);
#define PG8_SA(b, h) (((b) * 2 + (h)) * HTB)
#define PG8_SB(b, h) ((4 + (b) * 2 + (h)) * HTB)
#define PG8_STAGE(bufoff, gbase, voff) do { _Pragma("unroll") for (int _i = 0; _i < 2; ++_i) \
        __builtin_amdgcn_global_load_lds((const unsigned*)((const char*)(gbase) + (voff)[_i]), (PG8_LAS unsigned*)(lds + (bufoff) + ldsw + _i * 8192), 16, 0, 0); } while (0)
#define PG8_LDA(dst, b, h) do { _Pragma("unroll") for (int m = 0; m < 4; ++m) _Pragma("unroll") for (int k = 0; k < 2; ++k) dst[m][k] = *(const PG8_LAS bf16x8*)(lds + PG8_SA(b, h) + aoff + m * 2048 + k * 1024); } while (0)
#define PG8_LDB(dst, b, h) do { _Pragma("unroll") for (int n = 0; n < 2; ++n) _Pragma("unroll") for (int k = 0; k < 2; ++k) dst[n][k] = *(const PG8_LAS bf16x8*)(lds + PG8_SB(b, h) + boff + n * 2048 + k * 1024); } while (0)
#define PG8_MMA(ai, bj, At, Bt) do { __builtin_amdgcn_s_setprio(1); _Pragma("unroll") for (int m = 0; m < 4; ++m) _Pragma("unroll") for (int n = 0; n < 2; ++n) _Pragma("unroll") for (int k = 0; k < 2; ++k) \
        acc[ai][bj][m][n] = __builtin_amdgcn_mfma_f32_16x16x32_bf16(Bt[n][k], At[m][k], acc[ai][bj][m][n], 0, 0, 0); __builtin_amdgcn_s_setprio(0); } while (0)
#define PG8_WAIT_V(n) asm volatile("s_waitcnt vmcnt(" #n ")" ::: "memory")
#define PG8_WAIT_L(n) asm volatile("s_waitcnt lgkmcnt(" #n ")" ::: "memory")
#define PG8_BAR __builtin_amdgcn_s_barrier()
#define PG8_SCHED __builtin_amdgcn_sched_barrier(0)
    Unit cur, nxt; int ui = 0;
    if (!S.next(0, cur)) return;
    f32x4 acc[2][2][4][2];
#pragma unroll
    for (int a = 0; a < 2; ++a)
#pragma unroll
        for (int b = 0; b < 2; ++b)
#pragma unroll
            for (int m = 0; m < 4; ++m)
#pragma unroll
                for (int n = 0; n < 2; ++n) acc[a][b][m][n] = (f32x4){0.f, 0.f, 0.f, 0.f};
    bf16x8 At[4][2], B0[2][2], B1[2][2];
    const char* cA = (const char*)g.A + (size_t)cur.pm * tstep; const char* cB = (const char*)g.Bt + (size_t)cur.pn * tstep;
    S.a_ready(cur);
    if constexpr (SP2) {
        PG8_STAGE(PG8_SB(0, 0), cB, voffB); PG8_STAGE(PG8_SB(0, 1), cB + hstep, voffB); PG8_STAGE(PG8_SA(0, 0), cA, voffA); PG8_STAGE(PG8_SA(0, 1), cA + hstep, voffA);
        if (wr == 1) PG8_BAR;
        PG8_WAIT_V(2); PG8_BAR;
        PG8_STAGE(PG8_SB(1, 0), cB + kstep, voffB); PG8_STAGE(PG8_SA(1, 0), cA + kstep, voffA); PG8_STAGE(PG8_SB(1, 1), cB + hstep + kstep, voffB);
        PG8_WAIT_V(6); PG8_BAR;
    } else {
        PG8_STAGE(PG8_SB(0, 0), cB, voffB); PG8_STAGE(PG8_SA(0, 0), cA, voffA); PG8_STAGE(PG8_SB(0, 1), cB + hstep, voffB); PG8_STAGE(PG8_SA(0, 1), cA + hstep, voffA);
        if (wr == 1) PG8_BAR;
        PG8_WAIT_V(4); PG8_BAR;
        PG8_STAGE(PG8_SB(1, 0), cB + kstep, voffB); PG8_STAGE(PG8_SA(1, 0), cA + kstep, voffA); PG8_STAGE(PG8_SB(1, 1), cB + hstep + kstep, voffB);
        PG8_WAIT_V(6); PG8_BAR;
    }
    for (;;) {
        const bool has_next = S.next(ui + 1, nxt);
        const char* nA = has_next ? (const char*)g.A + (size_t)nxt.pm * tstep : cA; const char* nB = has_next ? (const char*)g.Bt + (size_t)nxt.pn * tstep : cB;
        for (int t = 0; t < nt; t += 2) {
            const bool last = (t == nt - 2);
            const char* a1 = cA + (size_t)(t + 1) * kstep;
            const char* a2 = last ? nA : cA + (size_t)(t + 2) * kstep; const char* b2 = last ? nB : cB + (size_t)(t + 2) * kstep;
            const char* a3 = a2 + kstep; const char* b3 = b2 + kstep;
            if (last && has_next) S.a_ready(nxt);
            if constexpr (SP2) {
            PG8_LDB(B0, 0, 0); PG8_LDB(B1, 0, 1); PG8_SCHED; PG8_LDA(At, 0, 0); PG8_STAGE(PG8_SA(1, 1), a1 + hstep, voffA);
            PG8_WAIT_V(8); PG8_WAIT_L(0); PG8_BAR; PG8_MMA(0, 0, At, B0); PG8_MMA(0, 1, At, B1); PG8_BAR; PG8_SCHED;
            PG8_LDA(At, 0, 1); PG8_STAGE(PG8_SB(0, 0), b2, voffB); PG8_STAGE(PG8_SB(0, 1), b2 + hstep, voffB); PG8_STAGE(PG8_SA(0, 0), a2, voffA);
            PG8_WAIT_V(8); PG8_WAIT_L(0); PG8_BAR; PG8_MMA(1, 0, At, B0); PG8_MMA(1, 1, At, B1); PG8_BAR; PG8_SCHED;
            PG8_LDB(B0, 1, 0); PG8_LDB(B1, 1, 1); PG8_SCHED; PG8_LDA(At, 1, 0); PG8_STAGE(PG8_SA(0, 1), a2 + hstep, voffA);
            PG8_WAIT_V(8); PG8_WAIT_L(0); PG8_BAR; PG8_MMA(0, 0, At, B0); PG8_MMA(0, 1, At, B1); PG8_BAR; PG8_SCHED;
            PG8_LDA(At, 1, 1); PG8_STAGE(PG8_SB(1, 0), b3, voffB); PG8_STAGE(PG8_SB(1, 1), b3 + hstep, voffB); PG8_STAGE(PG8_SA(1, 0), a3, voffA);
            PG8_WAIT_V(8); PG8_WAIT_L(0); PG8_BAR; PG8_MMA(1, 0, At, B0); PG8_MMA(1, 1, At, B1); PG8_BAR; PG8_SCHED;
            } else {
            PG8_LDB(B0, 0, 0); PG8_SCHED; PG8_LDA(At, 0, 0); PG8_STAGE(PG8_SA(1, 1), a1 + hstep, voffA);
            PG8_WAIT_L(8); PG8_BAR; PG8_WAIT_L(0); PG8_MMA(0, 0, At, B0); PG8_BAR; PG8_SCHED;
            PG8_LDB(B1, 0, 1); PG8_STAGE(PG8_SB(0, 0), b2, voffB);
            PG8_BAR; PG8_WAIT_L(0); PG8_MMA(0, 1, At, B1); PG8_BAR;
            PG8_LDA(At, 0, 1); PG8_STAGE(PG8_SA(0, 0), a2, voffA);
            PG8_BAR; PG8_WAIT_L(0); PG8_MMA(1, 0, At, B0); PG8_BAR; PG8_SCHED;
            PG8_STAGE(PG8_SB(0, 1), b2 + hstep, voffB);
            PG8_WAIT_V(6); PG8_BAR; PG8_MMA(1, 1, At, B1); PG8_BAR;
            PG8_LDB(B0, 1, 0); PG8_SCHED; PG8_LDA(At, 1, 0); PG8_STAGE(PG8_SA(0, 1), a2 + hstep, voffA);
            PG8_WAIT_L(8); PG8_BAR; PG8_WAIT_L(0); PG8_MMA(0, 0, At, B0); PG8_BAR; PG8_SCHED;
            PG8_LDB(B1, 1, 1); PG8_STAGE(PG8_SB(1, 0), b3, voffB);
            PG8_BAR; PG8_WAIT_L(0); PG8_MMA(0, 1, At, B1); PG8_BAR;
            PG8_LDA(At, 1, 1); PG8_STAGE(PG8_SA(1, 0), a3, voffA);
            PG8_BAR; PG8_WAIT_L(0); PG8_MMA(1, 0, At, B0); PG8_BAR; PG8_SCHED;
            PG8_STAGE(PG8_SB(1, 1), b3 + hstep, voffB);
            PG8_WAIT_V(6); PG8_BAR; PG8_MMA(1, 1, At, B1); PG8_BAR;
            }
        }
        if constexpr (ALIGN_EPI) { if (wr == 0) PG8_BAR; }
        if constexpr (!Epi::AFTER_DRAIN) { E(acc, cur, wr, wc, fr, fq); S.done(cur); }
        if (!has_next) break;
#pragma unroll
        for (int a = 0; a < 2; ++a)
#pragma unroll
            for (int b = 0; b < 2; ++b)
#pragma unroll
                for (int m = 0; m < 4; ++m)
#pragma unroll
                    for (int n = 0; n < 2; ++n) acc[a][b][m][n] = (f32x4){0.f, 0.f, 0.f, 0.f};
        cur = nxt; cA = nA; cB = nB; ++ui;
        if constexpr (ALIGN_EPI) { if (wr == 1) PG8_BAR; }
    }
    PG8_WAIT_V(0);
    if constexpr (!ALIGN_EPI) { if (wr == 0) PG8_BAR; }
    PG8_BAR;
    if constexpr (Epi::AFTER_DRAIN) { E.fused(acc, cur, wr, wc, fr, fq, lds, wid, lane); S.done(cur); }
#undef PG8_SA
#undef PG8_SB
#undef PG8_STAGE
#undef PG8_LDA
#undef PG8_LDB
#undef PG8_MMA
#undef PG8_WAIT_V
#undef PG8_WAIT_L
#undef PG8_BAR
#undef PG8_SCHED
}
}

constexpr int NWAVES = 8;
#ifndef MK_N_LAUNCHES
#define MK_N_LAUNCHES 1
#endif
constexpr int NPHASE = 13;
constexpr int N_LAUNCHES = MK_N_LAUNCHES;

constexpr size_t MiB = 1u << 20;
constexpr size_t WS_CTL = 0, CTL_ZERO_BYTES = 1 * MiB;
constexpr size_t WS_MOD = 1 * MiB;
constexpr size_t WS_RT1 = 3 * MiB;
constexpr size_t WS_RT2 = 4 * MiB + 512 * 1024;
constexpr size_t WS_IWF = 5 * MiB;
constexpr size_t WS_WGU1 = 6 * MiB, WS_WD1 = 17 * MiB, WS_WIN = 23 * MiB, WS_WOUT = 32 * MiB, WS_WGU2 = 34 * MiB, WS_WD2 = 45 * MiB;
constexpr size_t WS_IKB = 51 * MiB;
constexpr size_t WS_MASK = 54 * MiB;
constexpr size_t WS_H = 64 * MiB;
constexpr size_t WS_XT = 98 * MiB;
constexpr size_t WS_ACT = 166 * MiB;
constexpr size_t WS_RQ = 166 * MiB, WS_RK = 183 * MiB, WS_RV = 200 * MiB, WS_SG = 217 * MiB, WS_AQ = 234 * MiB, WS_AK = 251 * MiB, WS_AV = 268 * MiB, WS_IQ = 285 * MiB;
constexpr size_t WS_END = 302 * MiB;
constexpr int MASKP = 36;
static_assert(WS_ACT + (size_t)MROWS * FF * 2 <= 260 * MiB && WS_IQ + (size_t)MROWS * 512 * 2 <= WS_END && WS_XT + (size_t)MROWS * DM * 4 <= WS_ACT && WS_H + (size_t)MROWS * DM * 2 <= WS_XT, "d_ws map");
static_assert(WS_MASK + (size_t)MROWS * MASKP * 8 <= WS_H && WS_WD2 + (size_t)DM * FF * 2 <= WS_IKB && WS_MOD + 40 * NMOD * 4 <= WS_RT1 && WS_RT1 + 2080 * 64 * 8 <= WS_RT2 && WS_RT2 + 2080 * 8 * 8 <= WS_IWF && WS_IWF + (size_t)MROWS * 32 <= WS_WGU1, "d_ws map 2");
constexpr int CW_TMO = 0, CW_CODE = 1;
constexpr int CW_TICKET = 64;
constexpr int CW_BAR = 4096;
constexpr int LDS_BYTES = 147456;
constexpr int MISC_OFF = LDS_BYTES - 128;
constexpr int RING_BYTES = 131072;

#define GAS __attribute__((address_space(1)))
#define LAS __attribute__((address_space(3)))
typedef unsigned short bf16;
typedef unsigned v4u __attribute__((ext_vector_type(4)));
typedef unsigned v2u __attribute__((ext_vector_type(2)));
typedef float f32x4 __attribute__((ext_vector_type(4)));
typedef float f32x2 __attribute__((ext_vector_type(2)));
typedef float f32x16 __attribute__((ext_vector_type(16)));
typedef short bf16x8 __attribute__((ext_vector_type(8)));
typedef short bf16x4 __attribute__((ext_vector_type(4)));
typedef GAS unsigned gu32;
typedef GAS unsigned long long gu64;
#define RLX_AGENT __ATOMIC_RELAXED, __HIP_MEMORY_SCOPE_AGENT
#define LDS_WAIT() asm volatile("s_waitcnt lgkmcnt(0)" ::: "memory")
#define VM_WAIT() asm volatile("s_waitcnt vmcnt(0)" ::: "memory")
__device__ __forceinline__ unsigned f2bf(float f) { unsigned u = __builtin_bit_cast(unsigned, f); return (u + 0x7fffu + ((u >> 16) & 1u)) >> 16; }
__device__ __forceinline__ unsigned pk2(float lo, float hi) { return f2bf(lo) | (f2bf(hi) << 16); }
__device__ __forceinline__ float bf2f(unsigned short b) { return __builtin_bit_cast(float, (unsigned)b << 16); }
__device__ __forceinline__ float bflo(unsigned w) { return __builtin_bit_cast(float, w << 16); }
__device__ __forceinline__ float bfhi(unsigned w) { return __builtin_bit_cast(float, w & 0xffff0000u); }
using pg8::batch_of_row; using pg8::pos_of_row; using pg8::silu_f;
#define XB_TMO      128
#define XB_XCNT(j)  (256  + 64 * (j))
#define XB_XSUB(j)  (1280 + 64 * (j))
#define XB_XGEN(j)  (2304 + 64 * (j))
#define XB_TOP      3328
#define XB_TOPGEN   3392
#define XCD_BAR_WORDS 3456
#define XB_SPIN_CAP (1u << 18)

__device__ __forceinline__ unsigned xb_ld(unsigned* p)              { return __hip_atomic_load(p, __ATOMIC_RELAXED, __HIP_MEMORY_SCOPE_AGENT); }
__device__ __forceinline__ unsigned xb_add(unsigned* p, unsigned v) { return __hip_atomic_fetch_add(p, v, __ATOMIC_RELAXED, __HIP_MEMORY_SCOPE_AGENT); }
__device__ __forceinline__ unsigned xb_xcc_id() { return (unsigned)__builtin_amdgcn_s_getreg((3 << 11) | 20) & 0xFu; }
#define XB_SPIN(cond, bar) do { unsigned _sp = 0; while (cond) { __builtin_amdgcn_s_sleep(1); \
    if ((++_sp & 255u) == 0u) { if (xb_ld(&(bar)[XB_TMO])) break; if (_sp > XB_SPIN_CAP) { atomicAdd(&(bar)[XB_TMO], 1u); break; } } } } while (0)

struct XcdBarrier {
    unsigned* bar; unsigned x;
    volatile LAS unsigned* st;
};

__device__ __forceinline__ XcdBarrier xcd_barrier_post(unsigned* bar, volatile LAS unsigned* st) {
    XcdBarrier b; b.bar = bar; b.x = xb_xcc_id(); b.st = st;
    if (threadIdx.x == 0) (void)xb_add(&bar[XB_XCNT(b.x)], 1u);
    return b;
}
__device__ __forceinline__ void xcd_barrier_complete(unsigned* bar, unsigned x, unsigned& nloc, unsigned& nx) {
    const unsigned G = gridDim.x * gridDim.y * gridDim.z;
    unsigned sum, cnt, mine, sp = 0u;
    for (;;) {
        sum = 0u; cnt = 0u; mine = 0u;
#pragma unroll
        for (unsigned j = 0; j < 16; ++j) { const unsigned c = xb_ld(&bar[XB_XCNT(j)]); sum += c; cnt += (c > 0u) ? 1u : 0u; mine = (j == x) ? c : mine; }
        if (sum == G) break;
        __builtin_amdgcn_s_sleep(1);
        if ((++sp & 255u) == 0u) { if (xb_ld(&bar[XB_TMO])) break; if (sp > XB_SPIN_CAP) { atomicAdd(&bar[XB_TMO], 1u); break; } }
    }
    nloc = mine > 0u ? mine : 1u; nx = cnt > 0u ? cnt : 1u;
}

__device__ __forceinline__ void xcd_barrier(const XcdBarrier& b) {
    asm volatile("s_waitcnt vmcnt(0)" ::: "memory");
    __syncthreads();
    if (threadIdx.x == 0) {
        unsigned* bar = b.bar;
        __builtin_amdgcn_s_waitcnt(0);
        unsigned nloc = b.st[0], nx = b.st[1];
        if (nloc == 0u) { xcd_barrier_complete(bar, b.x, nloc, nx); b.st[0] = nloc; b.st[1] = nx; }
        const unsigned old = xb_add(&bar[XB_XSUB(b.x)], 1u);
        const unsigned gen = old / nloc;
        if (old + 1u == (gen + 1u) * nloc) {
            __builtin_amdgcn_fence(__ATOMIC_RELEASE, "agent");
            asm volatile("s_waitcnt vmcnt(0)" ::: "memory");
            const unsigned og = xb_add(&bar[XB_TOP], 1u);
            const unsigned tg = og / nx;
            if (og + 1u == (tg + 1u) * nx) xb_add(&bar[XB_TOPGEN], 1u);
            else XB_SPIN(xb_ld(&bar[XB_TOPGEN]) == tg, bar);
            __builtin_amdgcn_fence(__ATOMIC_ACQUIRE, "agent");
            xb_add(&bar[XB_XGEN(b.x)], 1u);
            asm volatile("s_waitcnt vmcnt(0)" ::: "memory");
        } else {
            XB_SPIN(xb_ld(&bar[XB_XGEN(b.x)]) == gen, bar);
            __builtin_amdgcn_fence(__ATOMIC_ACQUIRE, "agent");
            asm volatile("s_waitcnt vmcnt(0)" ::: "memory");
        }
    }
    __syncthreads();
}

struct Args { const float* in[24]; float* out; unsigned char* ws; int ph_lo, ph_hi, li, pad; };
struct Frame {
    LAS unsigned char* lds;
    volatile LAS unsigned* MISC;
    const Args* a; unsigned char* ws;
    int tid, lane, wave, vcu, G;
    __device__ __forceinline__ gu32* ctl() const { return (gu32*)(ws + WS_CTL); }
    __device__ __forceinline__ float* out() const { return a->out; }
    __device__ __forceinline__ float* MOD() const { return (float*)(ws + WS_MOD); }
    __device__ __forceinline__ float* IWF() const { return (float*)(ws + WS_IWF); }
    __device__ __forceinline__ float* XT() const { return (float*)(ws + WS_XT); }
    __device__ __forceinline__ f32x2* RT1() const { return (f32x2*)(ws + WS_RT1); }
    __device__ __forceinline__ f32x2* RT2() const { return (f32x2*)(ws + WS_RT2); }
    __device__ __forceinline__ bf16* WGU1() const { return (bf16*)(ws + WS_WGU1); }
    __device__ __forceinline__ bf16* WD1() const { return (bf16*)(ws + WS_WD1); }
    __device__ __forceinline__ bf16* WIN() const { return (bf16*)(ws + WS_WIN); }
    __device__ __forceinline__ bf16* WOUT() const { return (bf16*)(ws + WS_WOUT); }
    __device__ __forceinline__ bf16* WGU2() const { return (bf16*)(ws + WS_WGU2); }
    __device__ __forceinline__ bf16* WD2() const { return (bf16*)(ws + WS_WD2); }
    __device__ __forceinline__ bf16* H() const { return (bf16*)(ws + WS_H); }
    __device__ __forceinline__ bf16* ACT() const { return (bf16*)(ws + WS_ACT); }
    __device__ __forceinline__ bf16* RQ() const { return (bf16*)(ws + WS_RQ); }
    __device__ __forceinline__ bf16* RK() const { return (bf16*)(ws + WS_RK); }
    __device__ __forceinline__ bf16* RV() const { return (bf16*)(ws + WS_RV); }
    __device__ __forceinline__ bf16* SG() const { return (bf16*)(ws + WS_SG); }
    __device__ __forceinline__ bf16* AQ() const { return (bf16*)(ws + WS_AQ); }
    __device__ __forceinline__ bf16* AK() const { return (bf16*)(ws + WS_AK); }
    __device__ __forceinline__ bf16* AV() const { return (bf16*)(ws + WS_AV); }
    __device__ __forceinline__ bf16* IQ() const { return (bf16*)(ws + WS_IQ); }
    __device__ __forceinline__ bf16* IKB() const { return (bf16*)(ws + WS_IKB); }
    __device__ __forceinline__ unsigned long long* MASK() const { return (unsigned long long*)(ws + WS_MASK); }
    __device__ __forceinline__ const float* xp() const { return a->in[0]; }
    __device__ __forceinline__ const float* xs() const { return a->in[1]; }
    __device__ __forceinline__ const float* cp() const { return a->in[2]; }
    __device__ __forceinline__ const float* cs() const { return a->in[3]; }
    __device__ __forceinline__ const float* cache_k() const { return a->in[4]; }
    __device__ __forceinline__ const float* cache_v() const { return a->in[5]; }
    __device__ __forceinline__ const float* cache_ik() const { return a->in[6]; }
    __device__ __forceinline__ const float* state_ret() const { return a->in[7]; }
    __device__ __forceinline__ const float* w_cond() const { return a->in[8]; }
    __device__ __forceinline__ const float* b_cond() const { return a->in[9]; }
    __device__ __forceinline__ const float* f1g() const { return a->in[10]; }
    __device__ __forceinline__ const float* f1u() const { return a->in[11]; }
    __device__ __forceinline__ const float* f1d() const { return a->in[12]; }
    __device__ __forceinline__ const float* ln1g() const { return a->in[13]; }
    __device__ __forceinline__ const float* ln1b() const { return a->in[14]; }
    __device__ __forceinline__ const float* w_in() const { return a->in[15]; }
    __device__ __forceinline__ const float* w_out() const { return a->in[16]; }
    __device__ __forceinline__ const float* ln2g() const { return a->in[17]; }
    __device__ __forceinline__ const float* ln2b() const { return a->in[18]; }
    __device__ __forceinline__ const float* f2g() const { return a->in[19]; }
    __device__ __forceinline__ const float* f2u() const { return a->in[20]; }
    __device__ __forceinline__ const float* f2d() const { return a->in[21]; }
    __device__ __forceinline__ const float* ln3g() const { return a->in[22]; }
    __device__ __forceinline__ const float* ln3b() const { return a->in[23]; }
};
__device__ __forceinline__ float wave_sum(float v) {
#pragma unroll
    for (int o = 1; o < 64; o <<= 1) v += __shfl_xor(v, o);
    return v;
}
__device__ __forceinline__ int wave_sum_i(int v) {
#pragma unroll
    for (int o = 1; o < 64; o <<= 1) v += __shfl_xor(v, o);
    return v;
}
__device__ __forceinline__ int next_ticket(Frame& F, int q) {
    __syncthreads();
    if (F.tid == 0) F.MISC[4] = __hip_atomic_fetch_add(F.ctl() + CW_TICKET + 64 * q, 1u, RLX_AGENT);
    __syncthreads();
    return (int)F.MISC[4];
}

struct SrcGU { const float* Wg; const float* Wu; __device__ __forceinline__ const float* operator()(int R) const { const int pn = R >> 8, c = R & 255; const uintptr_t a = (uintptr_t)Wg, b = (uintptr_t)Wu, m = (uintptr_t)0 - (uintptr_t)(c >= 128); return (const float*)((a & ~m) | (b & m)) + (pn * 128 + (c & 127)); } };
struct SrcPlain { const float* W; __device__ __forceinline__ const float* operator()(int R) const { return W + R; } };
__device__ __forceinline__ int rot_dim(int bj, int g) { const int fq = g >> 3, i = g & 7; return fq == 0 ? 8 * bj + i : 16 + 24 * bj + 8 * (fq - 1) + i; }
struct SrcWin { const float* W;
    __device__ __forceinline__ const float* operator()(int R) const {
        const int t = R >> 8, c = R & 255, bj = c >> 7, cc = c & 127; int col;
        if (t < 4) { const int head8 = 2 * t + (cc >> 6); col = head8 * 128 + (cc & 63) + 64 * bj; }
        else if (t < 6) col = 1024 + 256 * (t - 4) + c;
        else if (t < 8) col = 1536 + 256 * (t - 6) + c;
        else if (t == 12 || t == 13) col = 3072 + 256 * (t - 12) + c;
        else if (t < 16) { const int base = t < 10 ? 2048 : t < 12 ? 2560 : 3584; col = base + (4 * (t & 1) + (cc >> 5)) * 64 + rot_dim(bj, cc & 31); }
        else { const int hh = cc >> 5, g = cc & 31;
            if (hh == 0) col = 4096 + rot_dim(bj, g);
            else if (hh == 1 && bj == 0 && g < 8) col = 4160 + g;
            else return nullptr; }
        return W + col;
    }
};
template <class Src> __device__ __forceinline__ void p0_item(const Src& src, int N, int K, bf16* WT, LAS float* scr, int item, int lane) {
    const int nkb = K / 64, nb = item / nkb, kb = item % nkb, k0 = 64 * kb, n0 = 32 * nb;
    const float* cp = src(n0 + (lane & 31));
#pragma unroll 8
    for (int i = 0; i < 32; ++i) { const int kk = 2 * i + (lane >> 5); scr[kk * 33 + (lane & 31)] = cp ? cp[(size_t)(k0 + kk) * N] : 0.f; }
    LDS_WAIT(); asm volatile("" ::: "memory");
    const int c = lane & 7;
#pragma unroll
    for (int j = 0; j < 4; ++j) { const int n = (lane >> 3) + 8 * j; const LAS float* s = scr + (8 * c) * 33 + n;
        v4u o; o.x = pk2(s[0 * 33], s[1 * 33]); o.y = pk2(s[2 * 33], s[3 * 33]); o.z = pk2(s[4 * 33], s[5 * 33]); o.w = pk2(s[6 * 33], s[7 * 33]);
        *(GAS v4u*)(WT + (size_t)(n0 + n) * K + k0 + 8 * c) = o; }
    LDS_WAIT(); asm volatile("" ::: "memory");
}
__device__ const double INVREV1[64] = {0.15915494309189535, 0.13782250260398285, 0.11934937021124886, 0.10335229661843406, 0.08949940160889101, 0.07750328875537406, 0.06711508300522726, 0.058119267441876246, 0.050329212104487035, 0.04358330210530733, 0.03774158471741977, 0.032682865872357, 0.0283021958306234, 0.024508691862069852, 0.02122365276477766, 0.018378926105679667, 0.015915494309189534, 0.013782250260398284, 0.011934937021124886, 0.010335229661843406, 0.008949940160889102, 0.0077503288755374055, 0.006711508300522725, 0.005811926744187624, 0.005032921210448704, 0.004358330210530733, 0.003774158471741977, 0.0032682865872356993, 0.00283021958306234, 0.002450869186206985, 0.0021223652764777662, 0.0018378926105679667, 0.0015915494309189536, 0.0013782250260398288, 0.0011934937021124885, 0.0010335229661843405, 0.0008949940160889102, 0.0007750328875537405, 0.0006711508300522726, 0.0005811926744187624, 0.0005032921210448703, 0.0004358330210530733, 0.00037741584717419774, 0.0003268286587235699, 0.00028302195830623395, 0.00024508691862069854, 0.0002122365276477766, 0.00018378926105679666, 0.00015915494309189535, 0.00013782250260398286, 0.00011934937021124886, 0.00010335229661843406, 8.949940160889102e-05, 7.750328875537406e-05, 6.711508300522725e-05, 5.811926744187624e-05, 5.0329212104487035e-05, 4.358330210530732e-05, 3.774158471741978e-05, 3.2682865872357e-05, 2.8302195830623396e-05, 2.4508691862069852e-05, 2.122365276477766e-05, 1.8378926105679668e-05};
__device__ const double INVREV2[8] = {0.15915494309189535, 0.03086376340470123, 0.005985185712713705, 0.001160663641240061, 0.00022507907903927653, 4.364795279280289e-05, 8.464330808241401e-06, 1.6414262627950345e-06};

__device__ __forceinline__ void p0_prologue(Frame& F) {
    for (int chunk = blockIdx.x; chunk < NMOD / 64; chunk += F.G) {
        LAS float* sw = (LAS float*)(F.lds) + F.wave * (40 * 64);
        const int n = chunk * 64 + F.lane;
        float acc[40];
#pragma unroll
        for (int b = 0; b < 40; ++b) acc[b] = 0.f;
        for (int sub = 0; sub < 2; ++sub) {
            const int kb = F.wave * 128 + sub * 64;
#pragma unroll 8
            for (int b = 0; b < 40; ++b) { const float c = (b < 8 ? F.cp() + b * DM : F.cs() + (b - 8) * DM)[kb + F.lane]; sw[b * 64 + F.lane] = silu_f(c); }
            LDS_WAIT(); asm volatile("" ::: "memory");
            for (int kk = 0; kk < 64; kk += 4) {
                const float* wp = F.w_cond() + (size_t)(kb + kk) * NMOD + n;
                const float w0 = wp[0], w1 = wp[NMOD], w2 = wp[2 * NMOD], w3 = wp[3 * NMOD];
#pragma unroll
                for (int b = 0; b < 40; ++b) { const f32x4 s = *(const LAS f32x4*)(sw + b * 64 + kk); acc[b] += s[0] * w0 + s[1] * w1 + s[2] * w2 + s[3] * w3; }
            }
            LDS_WAIT(); asm volatile("" ::: "memory");
        }
        __syncthreads();
        LAS float* red = (LAS float*)(F.lds);
#pragma unroll
        for (int b = 0; b < 40; ++b) red[(F.wave * 40 + b) * 64 + F.lane] = acc[b];
        __syncthreads();
        for (int o = F.tid; o < 40 * 64; o += NWAVES * 64) { const int b = o >> 6, nl = o & 63; float s = 0.f;
#pragma unroll
            for (int w = 0; w < 8; ++w) s += red[(w * 40 + b) * 64 + nl];
            F.MOD()[(size_t)b * NMOD + chunk * 64 + nl] = s + F.b_cond()[chunk * 64 + nl]; }
        __syncthreads();
    }
    { const int gt = F.vcu * (NWAVES * 64) + F.tid, NT = F.G * NWAVES * 64;
        for (int i = gt; i < 2080 * 64; i += NT) { const int pos = i >> 6, j = i & 63; const double rv = (double)pos * INVREV1[j]; const float fr = (float)(rv - __builtin_floor(rv));
            F.RT1()[i] = (f32x2){__builtin_amdgcn_cosf(fr), __builtin_amdgcn_sinf(fr)}; }
        for (int i = gt; i < 2080 * 8; i += NT) { const int pos = i >> 3, j = i & 7; const double rv = (double)pos * INVREV2[j]; const float fr = (float)(rv - __builtin_floor(rv));
            F.RT2()[i] = (f32x2){__builtin_amdgcn_cosf(fr), __builtin_amdgcn_sinf(fr)}; }
    }
    LAS float* scr = (LAS float*)(F.lds + F.wave * 16384);
    const int gw = F.vcu * NWAVES + F.wave, NGW = F.G * NWAVES;
    constexpr int I_GU = (NGU / 32) * (DM / 64), I_D = (DM / 32) * (FF / 64), I_IN = (NIN / 32) * (DM / 64), I_O = (DM / 32) * (DM / 64);
    constexpr int NITEMS = 2 * I_GU + 2 * I_D + I_IN + I_O;
    for (int it = gw; it < NITEMS; it += NGW) {
        int r = it;
        if (r < I_GU) { p0_item(SrcGU{F.f1g(), F.f1u()}, FF, DM, F.WGU1(), scr, r, F.lane); continue; } r -= I_GU;
        if (r < I_GU) { p0_item(SrcGU{F.f2g(), F.f2u()}, FF, DM, F.WGU2(), scr, r, F.lane); continue; } r -= I_GU;
        if (r < I_D) { p0_item(SrcPlain{F.f1d()}, DM, FF, F.WD1(), scr, r, F.lane); continue; } r -= I_D;
        if (r < I_D) { p0_item(SrcPlain{F.f2d()}, DM, FF, F.WD2(), scr, r, F.lane); continue; } r -= I_D;
        if (r < I_IN) { p0_item(SrcWin{F.w_in()}, DIN, DM, F.WIN(), scr, r, F.lane); continue; } r -= I_IN;
        p0_item(SrcPlain{F.w_out()}, DM, DM, F.WOUT(), scr, r, F.lane);
    }
}
__device__ __forceinline__ const float* xrow(const Frame& F, int m) { return m < MP ? F.xp() + (size_t)m * DM : F.xs() + (size_t)(m - MP) * DM; }
__device__ __forceinline__ void p1_modulate(Frame& F) {
    const int gw = F.vcu * NWAVES + F.wave, NGW = F.G * NWAVES;
    for (int m = gw; m < MROWS; m += NGW) {
        const GAS f32x4* xr = (const GAS f32x4*)xrow(F, m) + F.lane;
        const float* mp = F.MOD() + (size_t)batch_of_row(m) * NMOD;
        GAS unsigned long long* o8 = (GAS unsigned long long*)(F.H() + (size_t)m * DM) + F.lane;
#pragma unroll
        for (int j = 0; j < 4; ++j) { const f32x4 v = xr[64 * j]; const int c = 4 * F.lane + 256 * j;
            const f32x4 sh = *(const f32x4*)(mp + c), sc = *(const f32x4*)(mp + DM + c); const f32x4 h = v * (sc + 1.f) + sh;
            o8[64 * j] = (unsigned long long)pk2(h[0], h[1]) | ((unsigned long long)pk2(h[2], h[3]) << 32); }
    }
}
__device__ __forceinline__ void ln_pass(Frame& F, const float* Tin, float* Xout, bf16* Hout, const float* g, const float* b, int moff) {
    const int gw = F.vcu * NWAVES + F.wave, NGW = F.G * NWAVES;
    for (int m = gw; m < MROWS; m += NGW) {
        const GAS f32x4* xr = (const GAS f32x4*)(Tin + (size_t)m * DM) + F.lane;
        f32x4 v[4]; float s = 0.f;
#pragma unroll
        for (int j = 0; j < 4; ++j) { v[j] = xr[64 * j]; s += (v[j][0] + v[j][1]) + (v[j][2] + v[j][3]); }
        const float mean = wave_sum(s) * (1.f / DM); float s2 = 0.f;
#pragma unroll
        for (int j = 0; j < 4; ++j) { v[j] = v[j] - mean; s2 += (v[j][0] * v[j][0] + v[j][1] * v[j][1]) + (v[j][2] * v[j][2] + v[j][3] * v[j][3]); }
        const float rstd = 1.f / sqrtf(wave_sum(s2) * (1.f / DM) + LN_EPS);
        const float* mp = F.MOD() + (size_t)batch_of_row(m) * NMOD + moff;
        GAS f32x4* xo = (GAS f32x4*)(Xout + (size_t)m * DM) + F.lane;
#pragma unroll
        for (int j = 0; j < 4; ++j) { const int c = 4 * F.lane + 256 * j;
            const f32x4 y = v[j] * rstd * *(const f32x4*)(g + c) + *(const f32x4*)(b + c);
            xo[64 * j] = y;
            if (Hout) { const f32x4 sh = *(const f32x4*)(mp + c), sc = *(const f32x4*)(mp + DM + c); const f32x4 h = y * (sc + 1.f) + sh;
                ((GAS unsigned long long*)(Hout + (size_t)m * DM) + F.lane)[64 * j] = (unsigned long long)pk2(h[0], h[1]) | ((unsigned long long)pk2(h[2], h[3]) << 32); }
        }
    }
}


template <int CTRL> __device__ __forceinline__ float dppf(float v) { return __builtin_bit_cast(float, __builtin_amdgcn_update_dpp(0, __builtin_bit_cast(int, v), CTRL, 0xf, 0xf, false)); }
template <int CTRL> __device__ __forceinline__ int dppi(int v) { return __builtin_amdgcn_update_dpp(0, v, CTRL, 0xf, 0xf, false); }
__device__ __forceinline__ float row16_sum(float v) { v += dppf<0x128>(v); v += dppf<0x124>(v); v += dppf<0x122>(v); v += dppf<0x121>(v); return v; }
__device__ __forceinline__ int wave_total_i(int v) { v += dppi<0x128>(v); v += dppi<0x124>(v); v += dppi<0x122>(v); v += dppi<0x121>(v);
    return __builtin_amdgcn_readlane(v, 0) + __builtin_amdgcn_readlane(v, 16) + __builtin_amdgcn_readlane(v, 32) + __builtin_amdgcn_readlane(v, 48); }
typedef short v4i16_t __attribute__((ext_vector_type(4)));
__device__ __forceinline__ bf16x8 tr_frag(const LAS unsigned char* p, int pitch) {
    const v4i16_t lo = __builtin_amdgcn_ds_read_tr16_b64_v4i16((LAS v4i16_t*)p), hi = __builtin_amdgcn_ds_read_tr16_b64_v4i16((LAS v4i16_t*)(p + 4 * pitch));
    return (bf16x8){lo[0], lo[1], lo[2], lo[3], hi[0], hi[1], hi[2], hi[3]};
}

constexpr int RT_Q = 0, RT_K = 17408, RT_V = 34816, RT_SC = 52224, RT_ST = 61440, RT_OUT = 96256, RT_STATS = 113664, RT_ROW = 117760, RT_G = 118272, RT_END = 135680;
template <int C> __device__ __forceinline__ void ret_unit(Frame& F, int rowbase, int nchunks, int h, const float* S0, float* Sout) {
    constexpr int NR = C / 16, KS = C / 32, NP = C / 32;
    const int tid = F.tid, lane = F.lane, w = F.wave, fr = lane & 15, fq = lane >> 4;
    LAS unsigned char* L = F.lds;
    const float lg2g = log2f(1.f - exp2f(-5.f - (float)h));
    const float gC = exp2f(lg2g * (float)C);
    f32x4 S[8];
    asm volatile("" : "+s"(nchunks));
    if (S0) {
#pragma unroll 2
        for (int i = 0; i < 8; ++i) *(LAS f32x4*)(L + (tid + 512 * i) * 16) = *(const GAS f32x4*)(S0 + (size_t)(tid + 512 * i) * 4);
        __syncthreads();
#pragma unroll
        for (int T = 0; T < 8; ++T)
#pragma unroll
            for (int i = 0; i < 4; ++i) S[T][i] = *(const LAS float*)(L + ((16 * T + 4 * fq + i) * 128 + 16 * w + fr) * 4);
        __syncthreads();
    } else {
#pragma unroll
        for (int T = 0; T < 8; ++T) S[T] = (f32x4){0.f, 0.f, 0.f, 0.f};
    }
#pragma unroll
    for (int T = 0; T < 8; ++T) *(LAS v2u*)(L + RT_ST + (16 * w + fr) * 272 + (16 * T + 4 * fq) * 2) = (v2u){pk2(S[T][0], S[T][1]), pk2(S[T][2], S[T][3])};
    v4u qreg[NP], kreg[NP], vreg[NP], greg[NP];
#define RET_ISSUE(c_) do { _Pragma("unroll") for (int p = 0; p < NP; ++p) { const int idx = tid + 512 * p, row = idx >> 4, col = (idx & 15) * 8; const size_t off = (size_t)(rowbase + C * (c_) + row) * 512 + h * 128 + col; \
            qreg[p] = *(const GAS v4u*)(F.RQ() + off); kreg[p] = *(const GAS v4u*)(F.RK() + off); vreg[p] = *(const GAS v4u*)(F.RV() + off); greg[p] = *(const GAS v4u*)(F.SG() + off); } } while (0)
#define RET_STORE(c_) do { _Pragma("unroll") for (int p = 0; p < NP; ++p) { const int idx = tid + 512 * p, row = idx >> 4, col = (idx & 15) * 8; \
            *(GAS v4u*)(F.H() + (size_t)(rowbase + C * (c_) + row) * DM + h * 128 + col) = *(const LAS v4u*)(L + RT_OUT + row * 272 + col * 2); } } while (0)
    RET_ISSUE(0);
    f32x4 oT[NR]; v2u gtp[NR];
    __syncthreads();
    for (int c = 0;; ++c) {
        int fqo = fq, fro = fr; asm volatile("" : "+v"(fqo), "+v"(fro));
        if (c < nchunks) {
#pragma unroll
            for (int p = 0; p < NP; ++p) { const int idx = tid + 512 * p, row = idx >> 4, col = (idx & 15) * 8;
                const float fqs = exp2f(lg2g * (float)(row - (C - 1))), fks = exp2f(lg2g * (float)(C - 1 - row));
                v4u qs, ks;
#pragma unroll
                for (int jj = 0; jj < 4; ++jj) { qs[jj] = pg8::cvt_pk_bf16(bflo(qreg[p][jj]) * fqs, bfhi(qreg[p][jj]) * fqs); ks[jj] = pg8::cvt_pk_bf16(bflo(kreg[p][jj]) * fks, bfhi(kreg[p][jj]) * fks); }
                *(LAS v4u*)(L + RT_Q + row * 272 + col * 2) = qs; *(LAS v4u*)(L + RT_K + row * 272 + col * 2) = ks;
                *(LAS v4u*)(L + RT_V + row * 272 + col * 2) = vreg[p]; *(LAS v4u*)(L + RT_G + row * 272 + col * 2) = greg[p]; }
            if (c + 1 < nchunks) RET_ISSUE(c + 1);
        }
        if (c >= 2) RET_STORE(c - 2);
        if (c >= 1 && tid < C) {
            const LAS f32x2* st = (const LAS f32x2*)(L + RT_STATS) + tid * 8; float s1 = 0.f, s2 = 0.f;
#pragma unroll
            for (int k = 0; k < 8; ++k) { const f32x2 e = st[k]; s1 += e[0]; s2 += e[1]; }
            const float mean = s1 * (1.f / 128.f), var = __builtin_fmaxf(s2 * (1.f / 128.f) - mean * mean, 0.f);
            ((LAS f32x2*)(L + RT_ROW))[tid] = (f32x2){mean, 1.f / sqrtf(var + LN_EPS)};
        }
        __syncthreads();
        if (c >= 1) {
#pragma unroll
            for (int R = 0; R < NR; ++R) { const int n = 16 * R + fro; const f32x2 rs = ((const LAS f32x2*)(L + RT_ROW))[n];
                const f32x4 y = (oT[R] - rs[0]) * rs[1];
                *(LAS v2u*)(L + RT_OUT + n * 272 + (16 * w + 4 * fqo) * 2) = (v2u){pg8::cvt_pk_bf16(y[0] * bflo(gtp[R][0]), y[1] * bfhi(gtp[R][0])), pg8::cvt_pk_bf16(y[2] * bflo(gtp[R][1]), y[3] * bfhi(gtp[R][1]))}; }
        }
        if (c == nchunks) break;
        __builtin_amdgcn_sched_barrier(0);
        for (int tile = w; tile < NR * NR; tile += 8) { const int nt = tile / NR, mt = tile % NR;
            f32x4 a = (f32x4){0.f, 0.f, 0.f, 0.f};
            if (nt >= mt) {
#pragma unroll
                for (int s = 0; s < 4; ++s) { const bf16x8 qa = *(const LAS bf16x8*)(L + RT_Q + (16 * nt + fr) * 272 + (32 * s + 8 * fq) * 2), kb = *(const LAS bf16x8*)(L + RT_K + (16 * mt + fr) * 272 + (32 * s + 8 * fq) * 2);
                    a = __builtin_amdgcn_mfma_f32_16x16x32_bf16(kb, qa, a, 0, 0, 0); }
            }
            const int n = 16 * nt + fro, m0 = 16 * mt + 4 * fqo;
            *(LAS v2u*)(L + RT_SC + n * 144 + m0 * 2) = (v2u){pg8::cvt_pk_bf16(n >= m0 ? a[0] : 0.f, n >= m0 + 1 ? a[1] : 0.f), pg8::cvt_pk_bf16(n >= m0 + 2 ? a[2] : 0.f, n >= m0 + 3 ? a[3] : 0.f)};
        }
        __syncthreads();
        f32x4 oin[NR], ocr[NR];
#pragma unroll
        for (int R = 0; R < NR; ++R) { oin[R] = (f32x4){0.f, 0.f, 0.f, 0.f}; ocr[R] = (f32x4){0.f, 0.f, 0.f, 0.f}; }
        __builtin_amdgcn_sched_barrier(0);
        bf16x8 bv[KS];
        const LAS unsigned char* trb = L + (8 * fq + (fr >> 2)) * 272 + 8 * (fr & 3);
#pragma unroll
        for (int s = 0; s < KS; ++s) { bv[s] = tr_frag(trb + RT_V + (32 * s) * 272 + (16 * w) * 2, 272);
#pragma unroll
            for (int R = 0; R < NR; ++R) { const bf16x8 a = *(const LAS bf16x8*)(L + RT_SC + (16 * R + fr) * 144 + (32 * s + 8 * fq) * 2); oin[R] = __builtin_amdgcn_mfma_f32_16x16x32_bf16(bv[s], a, oin[R], 0, 0, 0); } }
        __builtin_amdgcn_sched_barrier(0);
#pragma unroll
        for (int s = 0; s < 4; ++s) { const bf16x8 bs = *(const LAS bf16x8*)(L + RT_ST + (16 * w + fr) * 272 + (32 * s + 8 * fq) * 2);
#pragma unroll
            for (int R = 0; R < NR; ++R) { const bf16x8 a = *(const LAS bf16x8*)(L + RT_Q + (16 * R + fr) * 272 + (32 * s + 8 * fq) * 2); ocr[R] = __builtin_amdgcn_mfma_f32_16x16x32_bf16(bs, a, ocr[R], 0, 0, 0); } }
        __builtin_amdgcn_sched_barrier(0);
#pragma unroll
        for (int R = 0; R < NR; ++R) oT[R] = oin[R] + ocr[R] * gC;
        __builtin_amdgcn_sched_barrier(0);
#pragma unroll
        for (int T = 0; T < 8; ++T) S[T] = S[T] * gC;
#pragma unroll
        for (int s = 0; s < KS; ++s)
#pragma unroll
            for (int T = 0; T < 8; ++T) { const bf16x8 a = tr_frag(trb + RT_K + (32 * s) * 272 + (16 * T) * 2, 272); S[T] = __builtin_amdgcn_mfma_f32_16x16x32_bf16(a, bv[s], S[T], 0, 0, 0); }
#pragma unroll
        for (int T = 0; T < 8; ++T) *(LAS v2u*)(L + RT_ST + (16 * w + fr) * 272 + (16 * T + 4 * fq) * 2) = (v2u){pk2(S[T][0], S[T][1]), pk2(S[T][2], S[T][3])};
        __builtin_amdgcn_sched_barrier(0);
#pragma unroll
        for (int R = 0; R < NR; ++R) { const f32x4 v = oT[R]; float s1 = (v[0] + v[1]) + (v[2] + v[3]), s2 = (v[0] * v[0] + v[1] * v[1]) + (v[2] * v[2] + v[3] * v[3]);
            s1 += __shfl_xor(s1, 16); s2 += __shfl_xor(s2, 16); s1 += __shfl_xor(s1, 32); s2 += __shfl_xor(s2, 32);
            const int n = 16 * R + fro;
            if (fq == 0) ((LAS f32x2*)(L + RT_STATS))[n * 8 + w] = (f32x2){s1, s2};
            gtp[R] = *(const LAS v2u*)(L + RT_G + n * 272 + (16 * w + 4 * fqo) * 2); }
        __syncthreads();
    }
    __syncthreads();
    RET_STORE(nchunks - 1);
#pragma unroll
    for (int T = 0; T < 8; ++T)
#pragma unroll
        for (int i = 0; i < 4; ++i) *(LAS float*)(L + ((16 * T + 4 * fq + i) * 128 + 16 * w + fr) * 4) = S[T][i];
    __syncthreads();
#pragma unroll 2
    for (int i = 0; i < 8; ++i) *(GAS f32x4*)(Sout + (size_t)(tid + 512 * i) * 4) = *(const LAS f32x4*)(L + (tid + 512 * i) * 16);
    __syncthreads();
#undef RET_ISSUE
#undef RET_STORE
}

constexpr int SCP = 2116;
__device__ __forceinline__ unsigned sortable(float v) { const unsigned u = __builtin_bit_cast(unsigned, v + 0.f); return (u & 0x80000000u) ? ~u : (u | 0x80000000u); }
__device__ __forceinline__ void mask_prefill(Frame& F) {
    const int gt = F.vcu * (NWAVES * 64) + F.tid, NT = F.G * NWAVES * 64;
    for (int i = gt; i < 8 * 256 * 33; i += NT) { const int rw = i / 33, t = i - rw * 33, b = rw >> 8, q = rw & 255;
        F.MASK()[(size_t)(b * 2048 + q) * MASKP + t] = (t <= (q >> 6)) ? ~0ull : 0ull; }
}
template <bool SAMPLE> __device__ __forceinline__ void idx_unit(Frame& F, int b, int g) {
    const int lane = F.lane, w = F.wave, fr = lane & 15, fq = lane >> 4;
    const int q0 = SAMPLE ? MP + b * 32 + 16 * g : b * 2048 + 16 * g;
    const int L = SAMPLE ? 2080 : 64 * ((g >> 2) + 1);
    LAS float* SC = (LAS float*)F.lds;
    bf16x8 bq[8][2]; float iw[8];
#pragma unroll
    for (int h = 0; h < 8; ++h) {
#pragma unroll
        for (int s = 0; s < 2; ++s) bq[h][s] = *(const GAS bf16x8*)(F.IQ() + (size_t)(q0 + fr) * 512 + h * 64 + 32 * s + 8 * fq);
        iw[h] = F.IWF()[(size_t)(q0 + fr) * 8 + h];
    }
    __syncthreads();
    f32x4 raw[4];
#define IDX_LOAD(t_) do { if (SAMPLE && (t_) < 128) { const float* kp = F.cache_ik() + ((size_t)b * 2048 + 16 * (t_) + fr) * 64 + 8 * fq; \
            raw[0] = *(const GAS f32x4*)(kp); raw[1] = *(const GAS f32x4*)(kp + 4); raw[2] = *(const GAS f32x4*)(kp + 32); raw[3] = *(const GAS f32x4*)(kp + 36); } \
        else { const size_t krow = SAMPLE ? (size_t)(MP + b * 32 + (16 * (t_) - 2048) + fr) : (size_t)(b * 2048 + 16 * (t_) + fr); \
            raw[0] = *(const GAS f32x4*)(F.IKB() + krow * 64 + 8 * fq); raw[1] = *(const GAS f32x4*)(F.IKB() + krow * 64 + 32 + 8 * fq); } } while (0)
    const int ntile = L / 16;
    if (w < ntile) IDX_LOAD(w);
    for (int t = w; t < ntile; t += 8) {
        bf16x8 a[2];
        if (SAMPLE && t < 128) {
            const v4u p0 = (v4u){pk2(raw[0][0], raw[0][1]), pk2(raw[0][2], raw[0][3]), pk2(raw[1][0], raw[1][1]), pk2(raw[1][2], raw[1][3])};
            const v4u p1 = (v4u){pk2(raw[2][0], raw[2][1]), pk2(raw[2][2], raw[2][3]), pk2(raw[3][0], raw[3][1]), pk2(raw[3][2], raw[3][3])};
            a[0] = __builtin_bit_cast(bf16x8, p0); a[1] = __builtin_bit_cast(bf16x8, p1);
        } else { a[0] = __builtin_bit_cast(bf16x8, raw[0]); a[1] = __builtin_bit_cast(bf16x8, raw[1]); }
        if (t + 8 < ntile) IDX_LOAD(t + 8);
        f32x4 sc = (f32x4){0.f, 0.f, 0.f, 0.f};
#pragma unroll
        for (int h = 0; h < 8; ++h) { f32x4 acc = (f32x4){0.f, 0.f, 0.f, 0.f};
            acc = __builtin_amdgcn_mfma_f32_16x16x32_bf16(a[0], bq[h][0], acc, 0, 0, 0); acc = __builtin_amdgcn_mfma_f32_16x16x32_bf16(a[1], bq[h][1], acc, 0, 0, 0);
#pragma unroll
            for (int i = 0; i < 4; ++i) sc[i] += iw[h] * __builtin_fmaxf(acc[i], 0.f); }
        *(LAS f32x4*)(SC + fr * SCP + 16 * t + 4 * fq) = sc;
    }
#undef IDX_LOAD
    __syncthreads();
    const int NI = (L + 63) >> 6;
    const unsigned long long lt = (1ull << lane) - 1ull;
    for (int qi = 0; qi < 2; ++qi) {
        const int qq = 2 * w + qi; const LAS float* sr = SC + qq * SCP;
        int ln = lane; asm volatile("" : "+v"(ln));
        unsigned u[33];
#pragma unroll
        for (int i = 0; i < 33; ++i) { const int key = 64 * i + ln; u[i] = (key < L) ? sortable(sr[key]) : 0u; }
        unsigned prefix = 0u; bool done = false;
        for (int bit = 31; bit >= 0; --bit) { const unsigned cand = prefix | (1u << bit); int c = 0;
#pragma unroll
            for (int i = 0; i < 33; ++i) c += (u[i] >= cand) ? 1 : 0;
            c = wave_total_i(c);
            if (c >= 256) { prefix = cand; if (c == 256) { done = true; break; } } }
        unsigned pgt = prefix; int need = 0;
        if (done) pgt = prefix - 1u;
        else { int cg = 0;
#pragma unroll
            for (int i = 0; i < 33; ++i) cg += (u[i] > prefix) ? 1 : 0;
            need = 256 - wave_total_i(cg); }
        int running = 0; unsigned long long mw = 0ull;
#pragma unroll
        for (int i = 0; i < 33; ++i) { if (i < NI) { const bool gt = u[i] > pgt, eq = (u[i] == pgt) && !done;
                const unsigned long long beq = __ballot(eq); const int rank = running + __popcll(beq & lt);
                const unsigned long long bsel = __ballot(gt || (eq && rank < need)); running += __popcll(beq);
                if (ln == i) mw = bsel; } __builtin_amdgcn_sched_barrier(0); }
        if (lane < 33) F.MASK()[(size_t)(q0 + qq) * MASKP + lane] = mw;
    }
}

__device__ __forceinline__ float fexp2(float x) { return __builtin_amdgcn_exp2f(x); }
__device__ __forceinline__ void att_tile(const LAS unsigned char* Kt, const LAS unsigned char* Vt, const bf16x8 (&qf)[4], unsigned long long mw, int r32, int hi, float& m_run, float& l_run, f32x16 (&ot)[2]) {
    f32x16 p0, p1;
#pragma unroll
    for (int r = 0; r < 16; ++r) { p0[r] = 0.f; p1[r] = 0.f; }
#pragma unroll
    for (int s = 0; s < 4; ++s) { const bf16x8 k0 = *(const LAS bf16x8*)(Kt + r32 * 144 + (16 * s + 8 * hi) * 2), k1 = *(const LAS bf16x8*)(Kt + (32 + r32) * 144 + (16 * s + 8 * hi) * 2);
        p0 = __builtin_amdgcn_mfma_f32_32x32x16_bf16(k0, qf[s], p0, 0, 0, 0); p1 = __builtin_amdgcn_mfma_f32_32x32x16_bf16(k1, qf[s], p1, 0, 0, 0); }
    const unsigned mlo = (unsigned)(mw >> (4 * hi)), mhi = (unsigned)(mw >> (32 + 4 * hi));
    float mx = -1e30f;
#pragma unroll
    for (int r = 0; r < 16; ++r) { const int bit = (r & 3) + 8 * (r >> 2);
        if ((mlo >> bit) & 1u) mx = __builtin_fmaxf(mx, p0[r]); if ((mhi >> bit) & 1u) mx = __builtin_fmaxf(mx, p1[r]); }
    mx = __builtin_fmaxf(mx, __shfl_xor(mx, 32));
    const float mn = __builtin_fmaxf(m_run, mx), alpha = fexp2(m_run - mn); m_run = mn;
    float ls = 0.f;
#pragma unroll
    for (int r = 0; r < 16; ++r) { const int bit = (r & 3) + 8 * (r >> 2);
        p0[r] = ((mlo >> bit) & 1u) ? fexp2(p0[r] - mn) : 0.f; p1[r] = ((mhi >> bit) & 1u) ? fexp2(p1[r] - mn) : 0.f; ls += p0[r] + p1[r]; }
    l_run = l_run * alpha + ls;
#pragma unroll
    for (int r = 0; r < 16; ++r) { ot[0][r] *= alpha; ot[1][r] *= alpha; }
    bf16x8 pa[2][2];
#pragma unroll
    for (int s2 = 0; s2 < 2; ++s2) {
        const v4u w0 = (v4u){pk2(p0[8 * s2], p0[8 * s2 + 1]), pk2(p0[8 * s2 + 2], p0[8 * s2 + 3]), pk2(p0[8 * s2 + 4], p0[8 * s2 + 5]), pk2(p0[8 * s2 + 6], p0[8 * s2 + 7])};
        const v4u w1 = (v4u){pk2(p1[8 * s2], p1[8 * s2 + 1]), pk2(p1[8 * s2 + 2], p1[8 * s2 + 3]), pk2(p1[8 * s2 + 4], p1[8 * s2 + 5]), pk2(p1[8 * s2 + 6], p1[8 * s2 + 7])};
        pa[0][s2] = __builtin_bit_cast(bf16x8, w0); pa[1][s2] = __builtin_bit_cast(bf16x8, w1); }
#pragma unroll
    for (int db = 0; db < 2; ++db)
#pragma unroll
        for (int kb = 0; kb < 2; ++kb)
#pragma unroll
            for (int s2 = 0; s2 < 2; ++s2) { const LAS unsigned char* vp = Vt + (32 * db + r32) * 136 + (32 * kb + 16 * s2 + 4 * hi) * 2;
                const v2u lo = *(const LAS v2u*)vp, hi4 = *(const LAS v2u*)(vp + 16); const v4u vv = (v4u){lo[0], lo[1], hi4[0], hi4[1]};
                ot[db] = __builtin_amdgcn_mfma_f32_32x32x16_bf16(__builtin_bit_cast(bf16x8, vv), pa[kb][s2], ot[db], 0, 0, 0); }
}
constexpr int AT_K = 0, AT_VT = 9216, AT_END = 9216 + 8704;
__device__ __forceinline__ void att_unit_prompt(Frame& F, int b, int h, int u8) {
    const int tid = F.tid, lane = F.lane, w = F.wave, r32 = lane & 31, hi = lane >> 5;
    LAS unsigned char* L = F.lds;
    const size_t rowb = (size_t)b * 2048; const int q0w = 256 * u8 + 32 * w, qc = q0w >> 6, ntw = qc + 1, NT = 4 * u8 + 4;
    bf16x8 qf[4];
#pragma unroll
    for (int s = 0; s < 4; ++s) qf[s] = *(const GAS bf16x8*)(F.AQ() + (rowb + q0w + r32) * 512 + h * 64 + 16 * s + 8 * hi);
    float m_run = -1e30f, l_run = 0.f; f32x16 ot[2];
#pragma unroll
    for (int r = 0; r < 16; ++r) { ot[0][r] = 0.f; ot[1][r] = 0.f; }
    const int key = tid >> 3, dch = tid & 7;
    for (int t = 0; t < NT; ++t) {
        const size_t goff = (rowb + 64 * t + key) * 512 + h * 64 + 8 * dch;
        const v4u kv = *(const GAS v4u*)(F.AK() + goff), vv = *(const GAS v4u*)(F.AV() + goff);
        unsigned long long mw = ~0ull;
        if (qc >= 4 && t < ntw) mw = F.MASK()[(rowb + q0w + r32) * MASKP + t];
        __syncthreads();
        *(LAS v4u*)(L + AT_K + key * 144 + dch * 16) = kv;
#pragma unroll
        for (int jj = 0; jj < 4; ++jj) { *(LAS unsigned short*)(L + AT_VT + (8 * dch + 2 * jj) * 136 + key * 2) = (unsigned short)(vv[jj] & 0xffffu);
            *(LAS unsigned short*)(L + AT_VT + (8 * dch + 2 * jj + 1) * 136 + key * 2) = (unsigned short)(vv[jj] >> 16); }
        __syncthreads();
        if (t < ntw) att_tile(L + AT_K, L + AT_VT, qf, mw, r32, hi, m_run, l_run, ot);
    }
    const float lt = l_run + __shfl_xor(l_run, 32), inv = 1.f / lt;
    bf16* op = F.H() + (rowb + q0w + r32) * DM + 512 + h * 64;
#pragma unroll
    for (int db = 0; db < 2; ++db)
#pragma unroll
        for (int rg = 0; rg < 4; ++rg) { const int d = 32 * db + 8 * rg + 4 * hi;
            *(GAS v2u*)(op + d) = (v2u){pk2(ot[db][4 * rg] * inv, ot[db][4 * rg + 1] * inv), pk2(ot[db][4 * rg + 2] * inv, ot[db][4 * rg + 3] * inv)}; }
    __syncthreads();
}
constexpr int SA_WB = 17920;
__device__ __forceinline__ void att_unit_sample(Frame& F, int b, int h) {
    const int tid = F.tid, lane = F.lane, w = F.wave, r32 = lane & 31, hi = lane >> 5;
    LAS unsigned char* Lw = F.lds + w * SA_WB;
    const size_t qrow = (size_t)MP + b * 32 + r32;
    bf16x8 qf[4];
#pragma unroll
    for (int s = 0; s < 4; ++s) qf[s] = *(const GAS bf16x8*)(F.AQ() + qrow * 512 + h * 64 + 16 * s + 8 * hi);
    float m_run = -1e30f, l_run = 0.f; f32x16 ot[2];
#pragma unroll
    for (int r = 0; r < 16; ++r) { ot[0][r] = 0.f; ot[1][r] = 0.f; }
    for (int t = w; t < 33; t += 8) {
        const unsigned long long mw = F.MASK()[qrow * MASKP + t];
        if (t < 32) {
#pragma unroll 4
            for (int i = 0; i < 16; ++i) { const int key = 4 * i + (lane >> 4), d4 = (lane & 15) * 4; const size_t go = (((size_t)b * 2048 + 64 * t + key) * 8 + h) * 64 + d4;
                const f32x4 kx = *(const GAS f32x4*)(F.cache_k() + go), vx = *(const GAS f32x4*)(F.cache_v() + go);
                *(LAS v2u*)(Lw + key * 144 + d4 * 2) = (v2u){pk2(kx[0], kx[1]), pk2(kx[2], kx[3])};
#pragma unroll
                for (int jj = 0; jj < 4; ++jj) *(LAS unsigned short*)(Lw + 9216 + (d4 + jj) * 136 + key * 2) = (unsigned short)f2bf(vx[jj]); }
        } else {
            for (int i = 0; i < 18; ++i) { const int o = (i * 64 + lane) * 16; if (o < SA_WB) *(LAS v4u*)(Lw + o) = (v4u){0u, 0u, 0u, 0u}; }
            LDS_WAIT(); asm volatile("" ::: "memory");
#pragma unroll
            for (int i = 0; i < 4; ++i) { const int key = 8 * i + (lane >> 3), d8 = (lane & 7) * 8; const size_t go = ((size_t)MP + b * 32 + key) * 512 + h * 64 + d8;
                const v4u kv = *(const GAS v4u*)(F.AK() + go), vv = *(const GAS v4u*)(F.AV() + go);
                *(LAS v4u*)(Lw + key * 144 + d8 * 2) = kv;
#pragma unroll
                for (int jj = 0; jj < 4; ++jj) { *(LAS unsigned short*)(Lw + 9216 + (d8 + 2 * jj) * 136 + key * 2) = (unsigned short)(vv[jj] & 0xffffu);
                    *(LAS unsigned short*)(Lw + 9216 + (d8 + 2 * jj + 1) * 136 + key * 2) = (unsigned short)(vv[jj] >> 16); } }
        }
        LDS_WAIT(); asm volatile("" ::: "memory");
        att_tile(Lw, Lw + 9216, qf, mw, r32, hi, m_run, l_run, ot);
        LDS_WAIT(); asm volatile("" ::: "memory");
    }
    __syncthreads();
    LAS float* Mx = (LAS float*)F.lds; LAS float* Lc = Mx + 256; LAS float* Oc = Mx + 512;
    if (hi == 0) Mx[w * 32 + r32] = m_run;
    __syncthreads();
    float ms = Mx[r32];
#pragma unroll
    for (int k = 1; k < 8; ++k) ms = __builtin_fmaxf(ms, Mx[k * 32 + r32]);
    const float scl = fexp2(m_run - ms); const float lt = (l_run + __shfl_xor(l_run, 32)) * scl;
    if (hi == 0) Lc[w * 32 + r32] = lt;
#pragma unroll
    for (int db = 0; db < 2; ++db)
#pragma unroll
        for (int rg = 0; rg < 4; ++rg) { const int d = 32 * db + 8 * rg + 4 * hi;
            *(LAS f32x4*)(Oc + (w * 32 + r32) * 64 + d) = (f32x4){ot[db][4 * rg] * scl, ot[db][4 * rg + 1] * scl, ot[db][4 * rg + 2] * scl, ot[db][4 * rg + 3] * scl}; }
    __syncthreads();
    { const int q = tid >> 4, d4 = (tid & 15) * 4; f32x4 s = (f32x4){0.f, 0.f, 0.f, 0.f}; float l = 0.f;
#pragma unroll
        for (int k = 0; k < 8; ++k) { s += *(const LAS f32x4*)(Oc + (k * 32 + q) * 64 + d4); l += Lc[k * 32 + q]; }
        const float inv = 1.f / l;
        *(GAS v2u*)(F.H() + ((size_t)MP + b * 32 + q) * DM + 512 + h * 64 + d4) = (v2u){pk2(s[0] * inv, s[1] * inv), pk2(s[2] * inv, s[3] * inv)}; }
    __syncthreads();
}

__global__ void __launch_bounds__(NWAVES * 64, 2) mk_fwd(Args args) {
    extern __shared__ __attribute__((aligned(16))) unsigned char lds[];
    Frame F;
    F.lds = (LAS unsigned char*)lds;
    F.MISC = (volatile LAS unsigned*)(F.lds + MISC_OFF);
    F.tid = threadIdx.x; F.lane = F.tid & 63; F.wave = __builtin_amdgcn_readfirstlane(F.tid >> 6);
    F.G = gridDim.x; { const int bx = blockIdx.x; F.vcu = (F.G % 8 == 0) ? (bx % 8) * (F.G / 8) + bx / 8 : bx; }
    F.a = &args; F.ws = args.ws;
    if (F.tid < 32) F.MISC[F.tid] = 0u;
    __syncthreads();
    XcdBarrier bar; bar.bar = (unsigned*)(F.ctl() + CW_BAR); bar.x = 0; bar.st = nullptr;
    if (N_LAUNCHES == 1) bar = xcd_barrier_post((unsigned*)(F.ctl() + CW_BAR), F.MISC + 8);
#define GRID_BAR() do { if (N_LAUNCHES == 1) xcd_barrier(bar); } while (0)
    const int lo = args.ph_lo, hi = args.ph_hi;
#ifndef P6SEL
#define P6SEL 15
#endif
#ifndef DUPSEL
#define DUPSEL 15
#endif
#ifndef DUPMASK
#define DUPMASK 0
#endif
#define REPS(k) (((DUPMASK >> (k)) & 1) ? 2 : 1)
#ifndef PHMASK
#define PHMASK 0x1fff
#endif
#define IN(k) (((PHMASK >> (k)) & 1) && lo <= (k) && (k) < hi)
#define BOTH(k) (IN(k) && IN((k) + 1))
    if (IN(0)) for (int rep = 0; rep < REPS(0); ++rep) { if (rep) GRID_BAR(); p0_prologue(F); if (BOTH(0)) GRID_BAR(); }
    if (IN(1)) for (int rep = 0; rep < REPS(1); ++rep) { if (rep) GRID_BAR(); p1_modulate(F); if (BOTH(1)) GRID_BAR(); }
    if (IN(2)) for (int rep = 0; rep < REPS(2); ++rep) { if (rep) GRID_BAR(); pg8::Gemm g{F.H(), F.WGU1(), MROWS, NGU, DM}; pg8::StaticOrder S; S.init(MROWS, NGU, F.G, (int)blockIdx.x); pg8::EpiSwiGLU E{F.ACT()};
        pg8::gemm_phase<pg8::EpiSwiGLU, pg8::StaticOrder, true, true>(F.lds, g, S, E); if (BOTH(2)) GRID_BAR(); }
    if (IN(3)) for (int rep = 0; rep < REPS(3); ++rep) { if (rep) GRID_BAR(); pg8::Gemm g{F.ACT(), F.WD1(), MROWS, DM, FF}; pg8::StaticOrder S; S.init(MROWS, DM, F.G, (int)blockIdx.x); pg8::EpiResid E{F.xp(), F.xs(), F.XT(), F.MOD(), 2 * DM, 0.5f};
        pg8::gemm_phase<pg8::EpiResid, pg8::StaticOrder, true, true>(F.lds, g, S, E); if (BOTH(3)) GRID_BAR(); }
    if (IN(4)) { ln_pass(F, F.XT(), F.XT(), F.H(), F.ln1g(), F.ln1b(), 3 * DM); if (BOTH(4)) GRID_BAR(); }
    if (IN(5)) for (int rep = 0; rep < REPS(5); ++rep) { if (rep) GRID_BAR(); pg8::Gemm g{F.H(), F.WIN(), MROWS, NIN, DM}; pg8::StaticOrder S; S.init(MROWS, NIN, F.G, (int)blockIdx.x);
        pg8::EpiMix E{F.RQ(), F.RK(), F.RV(), F.SG(), F.AQ(), F.AK(), F.AV(), F.IQ(), F.IKB(), F.IWF(), F.out(), F.RT1(), F.RT2()};
        pg8::gemm_phase<pg8::EpiMix, pg8::StaticOrder, true, true>(F.lds, g, S, E); if (BOTH(5)) GRID_BAR(); }
    if (IN(6)) for (int rep = 0; rep < REPS(6); ++rep) {
        if (rep) GRID_BAR();
        mask_prefill(F);
        for (;;) { const int t = next_ticket(F, 2 * rep); if (t >= 672) break;
            if (t < 32) { if ((rep ? DUPSEL : P6SEL) & 1) { const int b = t >> 2, h = t & 3; ret_unit<64>(F, b * 2048, 32, h, nullptr, F.out() + O_SRP + (size_t)t * 16384); } }
            else if (t < 480) { if ((rep ? DUPSEL : P6SEL) & 2) { const int p = t - 32, b = p / 56, k = p % 56; idx_unit<false>(F, b, 16 + k); idx_unit<false>(F, b, 127 - k); } }
            else if (t < 544) { if ((rep ? DUPSEL : P6SEL) & 4) { const int p = t - 480; idx_unit<true>(F, p >> 1, p & 1); } }
            else { if ((rep ? DUPSEL : P6SEL) & 8) { const int p = t - 544, b = p >> 2, h = p & 3; ret_unit<32>(F, MP + b * 32, 1, h, F.state_ret() + (size_t)p * 16384, F.out() + O_SRS + (size_t)p * 16384); } }
        }
        if (BOTH(6) && rep == REPS(6) - 1) GRID_BAR();
    }
    if (IN(7)) for (int rep = 0; rep < REPS(7); ++rep) {
        if (rep) GRID_BAR();
        for (;;) { const int t = next_ticket(F, 1 + 2 * rep); if (t >= 512) break;
            if (t < 256) { const int b = t >> 5, h = (t >> 2) & 7, k = t & 3; att_unit_prompt(F, b, h, 7 - k); att_unit_prompt(F, b, h, k); }
            else { const int p = t - 256; att_unit_sample(F, p >> 3, p & 7); }
        }
        if (BOTH(7) && rep == REPS(7) - 1) GRID_BAR();
    }
    if (IN(8)) { pg8::Gemm g{F.H(), F.WOUT(), MROWS, DM, DM}; pg8::StaticOrder S; S.init(MROWS, DM, F.G, (int)blockIdx.x); pg8::EpiResid E{F.XT(), F.XT() + (size_t)MP * DM, F.XT(), F.MOD(), 5 * DM, 1.0f};
        pg8::gemm_phase<pg8::EpiResid, pg8::StaticOrder, true, true>(F.lds, g, S, E); if (BOTH(8)) GRID_BAR(); }
    if (IN(9)) { ln_pass(F, F.XT(), F.XT(), F.H(), F.ln2g(), F.ln2b(), 6 * DM); if (BOTH(9)) GRID_BAR(); }
    if (IN(10)) for (int rep = 0; rep < REPS(10); ++rep) { if (rep) GRID_BAR(); pg8::Gemm g{F.H(), F.WGU2(), MROWS, NGU, DM}; pg8::StaticOrder S; S.init(MROWS, NGU, F.G, (int)blockIdx.x); pg8::EpiSwiGLU E{F.ACT()};
        pg8::gemm_phase<pg8::EpiSwiGLU, pg8::StaticOrder, true, true>(F.lds, g, S, E); if (BOTH(10)) GRID_BAR(); }
    if (IN(11)) { pg8::Gemm g{F.ACT(), F.WD2(), MROWS, DM, FF}; pg8::StaticOrder S; S.init(MROWS, DM, F.G, (int)blockIdx.x); pg8::EpiResid E{F.XT(), F.XT() + (size_t)MP * DM, F.XT(), F.MOD(), 8 * DM, 0.5f};
        pg8::gemm_phase<pg8::EpiResid, pg8::StaticOrder, true, true>(F.lds, g, S, E); if (BOTH(11)) GRID_BAR(); }
    if (IN(12)) { ln_pass(F, F.XT(), F.out(), nullptr, F.ln3g(), F.ln3b(), 0); }
#undef IN
#undef BOTH
#undef GRID_BAR
}

extern "C" void kernel_launch(void* const* d_in, const int* in_sizes, int n_in, void* d_out, int out_size, void* d_ws, size_t ws_size, hipStream_t stream) {
    static int grid = 0;
    if (grid == 0) {
        if (n_in != 24 || out_size != (int)O_END || ws_size < WS_END) { fprintf(stderr, "kernel_launch: unexpected sizes n_in %d out %d ws %zu\n", n_in, out_size, ws_size); grid = -1; return; }
        int dev = 0, cus = 0;
        if (hipGetDevice(&dev) != hipSuccess || hipDeviceGetAttribute(&cus, hipDeviceAttributeMultiprocessorCount, dev) != hipSuccess) { grid = -1; return; }
        if (hipFuncSetAttribute((const void*)mk_fwd, hipFuncAttributeMaxDynamicSharedMemorySize, LDS_BYTES) != hipSuccess) { fprintf(stderr, "kernel_launch: hipFuncSetAttribute failed\n"); grid = -1; return; }
        int per_cu = 0;
        if (hipOccupancyMaxActiveBlocksPerMultiprocessor(&per_cu, (const void*)mk_fwd, NWAVES * 64, LDS_BYTES) != hipSuccess || per_cu < 1) fprintf(stderr, "kernel_launch: occupancy query says %d\n", per_cu);
        (void)hipGetLastError();
        grid = cus;
    }
    if (grid < 0) return;
    (void)hipMemsetAsync((char*)d_ws + WS_CTL, 0, CTL_ZERO_BYTES, stream);
    Args a{};
    for (int i = 0; i < 24; ++i) a.in[i] = (const float*)d_in[i];
    a.out = (float*)d_out; a.ws = (unsigned char*)d_ws;
    if (N_LAUNCHES == 1) { a.ph_lo = 0; a.ph_hi = NPHASE; a.li = 0; hipLaunchKernelGGL(mk_fwd, dim3(grid), dim3(NWAVES * 64), LDS_BYTES, stream, a); }
    else for (int li = 0; li < NPHASE; ++li) { a.ph_lo = li; a.ph_hi = li + 1; a.li = li; hipLaunchKernelGGL(mk_fwd, dim3(grid), dim3(NWAVES * 64), LDS_BYTES, stream, a); }
}
```
